# Optimizing an MI355X kernel written in HIP

```python
import functools
import jax, jax.numpy as jnp
from jax import lax
import numpy as np

D_MODEL = 2048
BATCH = 4
SEQ = 2048
DEPTH = 2
DEC_BATCH = 32
DEC_SEQ = 1
PAST_LEN = 16384
PAGE_SIZE = 128

MIX_WIDTH = D_MODEL
HA = 4
DK_A = 128
DV_A = 128
A_WIDTH = HA * DV_A
HB = 8
KV_HEADS = 2
HEAD_DIM = 128
B_WIDTH = HB * HEAD_DIM
WINDOW = 128
HC = 4
DK_C = 128
DV_C = 128
C_WIDTH = HC * DV_C
CHUNK = 64
D_FF = 5632
CONV_W = 3
NORM_EPS = 1e-6

SPLIT_SIZES = (HA * DK_A, HA * DK_A, HA * DV_A, A_WIDTH,
               HB * HEAD_DIM, KV_HEADS * HEAD_DIM, KV_HEADS * HEAD_DIM,
               HC * DK_C, HC * DK_C, HC * DV_C, C_WIDTH)
IN_COLS = sum(SPLIT_SIZES)
SPLIT_POINTS = tuple(int(s) for s in np.cumsum(SPLIT_SIZES)[:-1])

kernel_name = 'hybrid_hgrn2_swa_retention_step'


def rms_norm(x, g):
    x32 = x.astype(jnp.float32)
    y = x32 * lax.rsqrt(jnp.mean(x32 * x32, axis=-1, keepdims=True) + NORM_EPS)
    return (y * g.astype(jnp.float32)).astype(x.dtype)


def head_rms_norm(o, g):
    H, Dv = o.shape[-2:]
    y = o * lax.rsqrt(jnp.mean(o * o, axis=-1, keepdims=True) + NORM_EPS)
    return y * g.astype(jnp.float32).reshape(H, Dv)


def head_group_norm(o, g):
    H, Dv = o.shape[-2:]
    c = o - jnp.mean(o, axis=-1, keepdims=True)
    y = c * lax.rsqrt(jnp.mean(c * c, axis=-1, keepdims=True) + NORM_EPS)
    return y * g.astype(jnp.float32).reshape(H, Dv)


def alibi_slopes():
    return jnp.exp2(-(8.0 / HB) * (jnp.arange(HB, dtype=jnp.float32) + 1.0))


def retention_log_gamma():
    return jnp.log1p(-jnp.exp2(-5.0 - jnp.arange(HC, dtype=jnp.float32)))


def scan_chunks(step, state0, xs, chunk):
    B, T = xs[0].shape[:2]
    nc = T // chunk
    xs_c = tuple(jnp.moveaxis(a.reshape((B, nc, chunk) + a.shape[2:]), 1, 0) for a in xs)
    state, out = lax.scan(step, state0, xs_c)
    out = jnp.moveaxis(out, 0, 1)
    return out.reshape((B, T) + out.shape[3:]), state


def hgrn2_chunk_step(S, inp):
    q, k, v, log_f = inp
    L = q.shape[1]
    b = jnp.cumsum(log_f, axis=1)
    causal = jnp.tril(jnp.ones((L, L), dtype=bool))
    diff = b[:, :, None] - b[:, None, :]
    decay = jnp.exp(jnp.where(causal[None, :, :, None, None], diff, -jnp.inf))
    att = jnp.einsum('bthd,bshd,btshd->bhts', q, k, decay)
    o = (jnp.einsum('bhts,bshv->bthv', att, v)
         + jnp.einsum('bthd,bhdv->bthv', q * jnp.exp(b), S))
    b_last = b[:, -1]
    S_new = (jnp.exp(b_last)[..., None] * S
             + jnp.einsum('bshd,bshv->bhdv', k * jnp.exp(b_last[:, None] - b), v))
    return S_new, o


def retention_chunk_step(S, inp, log_gamma):
    q, k, v = inp
    L = q.shape[1]
    pos = jnp.arange(L, dtype=jnp.float32)
    diff = pos[:, None] - pos[None, :]
    causal = diff >= 0
    dmat = jnp.where(causal[None], jnp.exp(jnp.where(causal, diff, 0.0)[None] * log_gamma[:, None, None]), 0.0)
    att = jnp.einsum('bthd,bshd->bhts', q, k) * dmat[None]
    inner = jnp.exp((pos[:, None] + 1.0) * log_gamma[None, :])
    o = (jnp.einsum('bhts,bshv->bthv', att, v)
         + jnp.einsum('bthd,bhdv->bthv', q, S) * inner[None, :, :, None])
    tail = jnp.exp((L - 1.0 - pos)[:, None] * log_gamma[None, :])
    S_new = (jnp.exp(L * log_gamma)[None, :, None, None] * S
             + jnp.einsum('bshd,bshv->bhdv', k * tail[None, :, :, None], v))
    return S_new, o


def sink_attention(q, k, v, dist, valid, sinks, slopes):
    lead = q.shape[:-3]
    Q, H, Dh = q.shape[-3:]
    kvh = k.shape[-2]
    G = H // kvh
    qg = q.reshape(lead + (Q, kvh, G, Dh))
    s = jnp.einsum('...qkgd,...skd->...kgqs', qg, k) * (Dh ** -0.5)
    s = s - slopes.reshape(kvh, G, 1, 1) * dist
    s = jnp.where(valid, s, -jnp.inf)
    sink = sinks.reshape(kvh, G, 1, 1)
    m = jnp.maximum(jnp.max(s, axis=-1, keepdims=True), sink)
    p = jnp.exp(s - m)
    denom = jnp.sum(p, axis=-1, keepdims=True) + jnp.exp(sink - m)
    o = jnp.einsum('...kgqs,...skd->...qkgd', p / denom, v)
    return o.reshape(lead + (Q, H, Dh))


def swa_prompt(q, k, v, sinks, slopes):
    B, T = q.shape[:2]
    nb = T // WINDOW
    qb = q.reshape(B, nb, WINDOW, HB, HEAD_DIM)
    kb = k.reshape(B, nb, WINDOW, KV_HEADS, HEAD_DIM)
    vb = v.reshape(B, nb, WINDOW, KV_HEADS, HEAD_DIM)
    pad = ((0, 0), (1, 0), (0, 0), (0, 0), (0, 0))
    kk = jnp.concatenate([jnp.pad(kb, pad)[:, :-1], kb], axis=2)
    vv = jnp.concatenate([jnp.pad(vb, pad)[:, :-1], vb], axis=2)
    qi = jnp.arange(WINDOW)[:, None]
    sj = jnp.arange(2 * WINDOW)[None, :]
    dist = WINDOW + qi - sj
    blk = jnp.arange(nb)[:, None, None]
    valid = (dist >= 0) & (dist < WINDOW) & ((sj >= WINDOW) | (blk > 0))
    o = sink_attention(qb, kk, vv, dist.astype(jnp.float32), valid[:, None, None], sinks, slopes)
    return o.reshape(B, T, HB, HEAD_DIM)


def swa_sample(q, k, v, k_cache, v_cache, sinks, slopes):
    T = q.shape[1]
    kk = jnp.concatenate([k_cache, k], axis=1)
    vv = jnp.concatenate([v_cache, v], axis=1)
    t = jnp.arange(T)[:, None]
    j = jnp.arange(WINDOW + T)[None, :]
    dist = WINDOW + t - j
    valid = (dist >= 0) & (dist < WINDOW)
    o = sink_attention(q, kk, vv, dist.astype(jnp.float32), valid, sinks, slopes)
    return o, kk[:, -WINDOW:], vv[:, -WINDOW:]


def conv_ffn(h, w_up, conv_w, conv_b, w_down, prefix):
    u = jnp.matmul(h, w_up)
    T = u.shape[1]
    up = jnp.concatenate([prefix.astype(u.dtype), u], axis=1)
    c = conv_b
    for j in range(CONV_W):
        c = c + conv_w[j] * up[:, j:j + T]
    gate, val = jnp.split(c, 2, axis=-1)
    y = jnp.matmul(jax.nn.gelu(gate) * val, w_down)
    return y, up[:, -(CONV_W - 1):]


def trunk_layer(x, s_hgrn, s_ret, conv_buf, k_cache, v_cache,
                norm1, w_in, lb, a_gain, sinks, c_gain, w_out,
                norm2, w_up, conv_w, conv_b, w_down):
    B, T, _ = x.shape
    f32 = jnp.float32
    chunk = CHUNK if T % CHUNK == 0 else T
    h = rms_norm(x, norm1)
    z = jnp.matmul(h, w_in).astype(f32)
    qa, fa, ia, ga, qb, kb, vb, qc, kc, vc, gc = jnp.split(z, SPLIT_POINTS, axis=-1)

    lb = lb.reshape(HA, DK_A)
    fa = fa.reshape(B, T, HA, DK_A)
    log_f = jnp.logaddexp(jnp.log(lb), jnp.log1p(-lb) + jax.nn.log_sigmoid(fa))
    k_a = (1.0 - lb) * jax.nn.sigmoid(-fa)
    o_a, s_hgrn_new = scan_chunks(
        hgrn2_chunk_step, s_hgrn,
        (qa.reshape(B, T, HA, DK_A), k_a, ia.reshape(B, T, HA, DV_A), log_f), chunk)
    o_a = (head_rms_norm(o_a, a_gain) * jax.nn.silu(ga.reshape(B, T, HA, DV_A))).reshape(B, T, A_WIDTH)

    qb = qb.reshape(B, T, HB, HEAD_DIM)
    kb = kb.reshape(B, T, KV_HEADS, HEAD_DIM)
    vb = vb.reshape(B, T, KV_HEADS, HEAD_DIM)
    slopes = alibi_slopes()
    sinks = sinks.astype(f32)
    if k_cache is None:
        o_b = swa_prompt(qb, kb, vb, sinks, slopes)
        k_win, v_win = kb[:, -WINDOW:], vb[:, -WINDOW:]
    else:
        o_b, k_win, v_win = swa_sample(qb, kb, vb, k_cache.astype(f32), v_cache.astype(f32), sinks, slopes)
    o_b = o_b.reshape(B, T, B_WIDTH)

    step_c = functools.partial(retention_chunk_step, log_gamma=retention_log_gamma())
    o_c, s_ret_new = scan_chunks(
        step_c, s_ret,
        (qc.reshape(B, T, HC, DK_C), kc.reshape(B, T, HC, DK_C) * (DK_C ** -0.5), vc.reshape(B, T, HC, DV_C)), chunk)
    o_c = (head_group_norm(o_c, c_gain) * jax.nn.silu(gc.reshape(B, T, HC, DV_C))).reshape(B, T, C_WIDTH)

    mix = jnp.concatenate([o_a, o_b, o_c], axis=-1).astype(x.dtype)
    x = x + jnp.matmul(mix, w_out)
    y, conv_new = conv_ffn(rms_norm(x, norm2), w_up, conv_w, conv_b, w_down, conv_buf)
    x = x + y
    dt = x.dtype
    return x, (s_hgrn_new.astype(dt), k_win.astype(dt), v_win.astype(dt), s_ret_new.astype(dt), conv_new.astype(dt))


def setup_inputs(seed: int = 0) -> dict:
    key = jax.random.key(seed)
    ks = jax.random.split(key, 24)
    f32 = jnp.float32

    def nrm(k, shape, scale):
        return jax.random.normal(k, shape, f32) * scale

    return {
        'x_prompt': nrm(ks[0], (BATCH, SEQ, D_MODEL), 1.0),
        'x_sample': nrm(ks[1], (DEC_BATCH, DEC_SEQ, D_MODEL), 1.0),
        'state_hgrn': nrm(ks[2], (DEPTH, DEC_BATCH, HA, DK_A, DV_A), 1.0),
        'cache_swa_k': nrm(ks[3], (DEPTH, DEC_BATCH, WINDOW, KV_HEADS, HEAD_DIM), 1.0),
        'cache_swa_v': nrm(ks[4], (DEPTH, DEC_BATCH, WINDOW, KV_HEADS, HEAD_DIM), 1.0),
        'state_ret': nrm(ks[5], (DEPTH, DEC_BATCH, HC, DK_C, DV_C), 1.0),
        'state_conv': nrm(ks[6], (DEPTH, DEC_BATCH, CONV_W - 1, 2 * D_FF), 1.0),
        'norm1_g': 1.0 + nrm(ks[7], (DEPTH, D_MODEL), 0.01),
        'w_in': nrm(ks[8], (DEPTH, D_MODEL, IN_COLS), D_MODEL ** -0.5),
        'hgrn_lb_raw': nrm(ks[9], (DEPTH, HA * DK_A), 1.0),
        'hgrn_norm_g': 1.0 + nrm(ks[10], (DEPTH, A_WIDTH), 0.01),
        'swa_sinks': nrm(ks[11], (DEPTH, HB), 1.0),
        'ret_norm_g': 1.0 + nrm(ks[12], (DEPTH, C_WIDTH), 0.01),
        'w_out': nrm(ks[13], (DEPTH, MIX_WIDTH, D_MODEL), MIX_WIDTH ** -0.5),
        'norm2_g': 1.0 + nrm(ks[14], (DEPTH, D_MODEL), 0.01),
        'w_up': nrm(ks[15], (DEPTH, D_MODEL, 2 * D_FF), D_MODEL ** -0.5),
        'conv_w': nrm(ks[16], (DEPTH, CONV_W, 2 * D_FF), CONV_W ** -0.5),
        'conv_b': nrm(ks[17], (DEPTH, 2 * D_FF), 0.01),
        'w_down': nrm(ks[18], (DEPTH, D_FF, D_MODEL), D_FF ** -0.5),
        'final_norm_g': 1.0 + nrm(ks[19], (D_MODEL,), 0.01),
    }


def reference(x_prompt, x_sample, state_hgrn, cache_swa_k, cache_swa_v, state_ret, state_conv,
              norm1_g, w_in, hgrn_lb_raw, hgrn_norm_g, swa_sinks, ret_norm_g, w_out,
              norm2_g, w_up, conv_w, conv_b, w_down, final_norm_g):
    f32 = jnp.float32
    lb_cum = jnp.cumsum(jax.nn.softmax(hgrn_lb_raw.astype(f32), axis=0), axis=0)
    lb_all = lb_cum - lb_cum[0]
    bp = x_prompt.shape[0]
    xp, xs = x_prompt, x_sample
    p_new, s_new = [], []
    for l in range(DEPTH):
        w = (norm1_g[l], w_in[l], lb_all[l], hgrn_norm_g[l], swa_sinks[l], ret_norm_g[l], w_out[l],
             norm2_g[l], w_up[l], conv_w[l], conv_b[l], w_down[l])
        xp, st_p = trunk_layer(xp,
                               jnp.zeros((bp, HA, DK_A, DV_A), f32),
                               jnp.zeros((bp, HC, DK_C, DV_C), f32),
                               jnp.zeros((bp, CONV_W - 1, 2 * D_FF), xp.dtype),
                               None, None, *w)
        p_new.append(st_p)
        xs, st_s = trunk_layer(xs,
                               state_hgrn[l].astype(f32),
                               state_ret[l].astype(f32),
                               state_conv[l],
                               cache_swa_k[l], cache_swa_v[l], *w)
        s_new.append(st_s)
    y_prompt = rms_norm(xp, final_norm_g)
    y_sample = rms_norm(xs, final_norm_g)
    p_hgrn, p_k, p_v, p_ret, p_conv = (jnp.stack(a) for a in zip(*p_new))
    s_hgrn, s_k, s_v, s_ret, s_conv = (jnp.stack(a) for a in zip(*s_new))
    return (y_prompt, y_sample, p_hgrn, p_k, p_v, p_ret, p_conv, s_hgrn, s_k, s_v, s_ret, s_conv)
```

```cpp
#include <hip/hip_runtime.h>
#include <cstdio>
#include <cstdint>
#include <cmath>
namespace cfg {
constexpr int DM = 2048, BATCH = 4, SEQ = 2048, DEPTH = 2, DB = 32, DFF = 5632, NCOL = 5632, NUP = 11264;
constexpr int MP = BATCH * SEQ;
constexpr float EPS = 1e-6f;
constexpr int C_QA = 0, C_FA = 512, C_IA = 1024, C_GA = 1536, C_QB = 2048, C_KB = 3072, C_VB = 3328, C_QC = 3584, C_KC = 4096, C_VC = 4608, C_GC = 5120;
constexpr size_t O_YP = 0, O_YS = 16777216, O_PHGRN = 16842752, O_PK = 17367040, O_PV = 17629184, O_PRET = 17891328, O_PCONV = 18415616,
                 O_SHGRN = 18595840, O_SK = 22790144, O_SV = 24887296, O_SRET = 26984448, O_SCONV = 31178752, O_END = 32620544;
}
__device__ __forceinline__ unsigned opq_u32(unsigned x) { asm volatile("" : "+v"(x)); return x; }
__device__ __forceinline__ unsigned long long opq_u64(unsigned long long x) { asm volatile("" : "+s"(x)); return x; }
namespace pg8 {
#define PG8_LAS __attribute__((address_space(3)))
typedef unsigned short bf16_t;
typedef short bf16x8 __attribute__((ext_vector_type(8)));
typedef float f32x4 __attribute__((ext_vector_type(4)));
typedef unsigned u32x4 __attribute__((ext_vector_type(4)));
constexpr int BM = 256, BK = 64, HALF = 128, HTB = HALF * BK * 2  , STAGE_BYTES = 8 * HTB, NXCD = 8, WGM = 4;

__host__ __device__ __forceinline__ int lds_byte(int r, int c) { const int st = (r >> 4) * 2 + (c >> 5), rr = r & 15, cc = c & 31, ob = rr * 64 + cc * 2; return st * 1024 + (ob ^ (((ob >> 9) & 1) << 5)); }
__host__ __device__ __forceinline__ void stage_rc(int b, int& R, int& C) { const int st = b / 1024, sb = b % 1024, swz = sb ^ (((sb >> 9) & 1) << 5); R = (st >> 1) * 16 + swz / 64; C = (st & 1) * 32 + (swz % 64) / 2; }
__host__ __device__ __forceinline__ int perm32(int rho) { const int n = rho >> 4, i = rho & 15; return 8 * (i >> 2) + 4 * n + (i & 3); }

struct Unit { int pm, pn; };
struct Gemm { const bf16_t* A; const bf16_t* Bt; int M, N, K; };

struct StaticOrder {
    int nM, nN, nwg, G, c;
    __host__ __device__ void init(int M, int N, int G_, int c_) { nM = M / BM; nN = N / BM; nwg = nM * nN; G = G_; c = c_; }
    __host__ __device__ bool next(int i, Unit& u) const {
        const long L = (long)i * G + c; if (L >= nwg) return false;
        int wgid = (int)L; { const int q = nwg / NXCD, r = nwg % NXCD, xcd = wgid % NXCD, off = wgid / NXCD; wgid = (xcd < r ? xcd * (q + 1) : r * (q + 1) + (xcd - r) * q) + off; }
        const int nig = WGM * nN, gid = wgid / nig, fm = gid * WGM, gsz = (nM - fm) < WGM ? (nM - fm) : WGM;
        u.pm = fm + ((wgid % nig) % gsz); u.pn = (wgid % nig) / gsz; return true;
    }
    __device__ __forceinline__ void a_ready(const Unit&) const {}
    __device__ __forceinline__ void done(const Unit&) const {}
};

struct InProjOrder {
    StaticOrder so; int c;
    __host__ __device__ void init(int M, int  , int G_, int c_) { so.init(M, 20 * BM, G_, c_); c = c_; }
    __host__ __device__ bool next(int i, Unit& u) const {
        if (so.G != 256) { StaticOrder full; full.init(so.nM * BM, 22 * BM, so.G, c); return full.next(i, u); }
        const int L = i * 256 + c; if (L >= 704) return false;
        if (L >= 448 && L < 512) { const int f = L - 448, x = f & 7, j = f >> 3; u.pm = 4 * x + (j & 3); u.pn = 2 + (j >> 2); return true; }
        StaticOrder t = so; t.c = c - (L >= 512 ? 64 : 0); if (!t.next(i, u)) return false;
        u.pn = u.pn < 2 ? u.pn : u.pn + 2; return true;
    }
    __device__ __forceinline__ void a_ready(const Unit&) const {}
    __device__ __forceinline__ void done(const Unit&) const {}
};

__device__ __forceinline__ unsigned cvt_pk_bf16(float lo, float hi) { unsigned r; asm volatile("v_cvt_pk_bf16_f32 %0, %1, %2" : "=v"(r) : "v"(lo), "v"(hi)); return r; }
__device__ __forceinline__ float row_rstd(const float* SS, int row) {
    const f32x4 a = *(const f32x4*)(SS + (size_t)row * 8), b = *(const f32x4*)(SS + (size_t)row * 8 + 4);
    const float s = ((a[0] + a[1]) + (a[2] + a[3])) + ((b[0] + b[1]) + (b[2] + b[3]));
    return 1.0f / sqrtf(s * (1.0f / 2048.0f) + 1e-6f);
}
__device__ __forceinline__ void fgate(float fa, float lb, float& ka, float& lf) {
    const float e = __builtin_amdgcn_exp2f(-1.4426950408889634f * fabsf(fa)), inv = __builtin_amdgcn_rcpf(1.0f + e);
    const float s = fa >= 0.f ? inv : e * inv, sm = fa >= 0.f ? e * inv : inv;
    ka = (1.0f - lb) * sm; lf = 0.6931471805599453f * __builtin_amdgcn_logf(lb + (1.0f - lb) * s);
}
struct EpiZ {
    static constexpr bool PERM = true, AFTER_DRAIN = false, HAS_NOSTORE = true;
    bf16_t* Z; float* LOGF; const float* SS; const float* lbraw; int layer; int ldz; PG8_LAS float* rsl;
    __device__ __forceinline__ void operator()(const f32x4 (&acc)[2][2][4][2], const Unit& u, int wr, int wc, int fr, int fq) const {
        const int row0 = u.pm * BM + wr * 64 + fr, col0 = u.pn * BM + wc * 32 + 8 * fq;
        const bool isF = (u.pn == 2 || u.pn == 3);
        { const int t = (int)opq_u32(threadIdx.x); if (t < 256) rsl[t] = row_rstd(SS, u.pm * BM + t);
          else if (isF) { const int c = u.pn * BM + (t - 256) - 512; rsl[t] = layer == 1 ? __builtin_amdgcn_rcpf(1.0f + __builtin_amdgcn_exp2f(1.4426950408889634f * (lbraw[c] - lbraw[512 + c]))) : 0.f; } }
        asm volatile("s_waitcnt vmcnt(0) lgkmcnt(0)" ::: "memory"); __builtin_amdgcn_s_barrier(); asm volatile("" ::: "memory");
#pragma unroll
        for (int ai = 0; ai < 2; ++ai)
#pragma unroll
            for (int m = 0; m < 4; ++m) { const int row = row0 + ai * HALF + m * 16; const float r = rsl[ai * HALF + wr * 64 + m * 16 + fr]; bf16_t* rowp = Z + (size_t)row * ldz + col0;
#pragma unroll
                for (int bj = 0; bj < 2; ++bj) { f32x4 v0 = acc[ai][bj][m][0] * r, v1 = acc[ai][bj][m][1] * r;
                    if (isF) { f32x4 l0, l1;
                        const f32x4 lb0 = *(const PG8_LAS f32x4*)(rsl + 256 + wc * 32 + 8 * fq + bj * HALF), lb1 = *(const PG8_LAS f32x4*)(rsl + 256 + wc * 32 + 8 * fq + bj * HALF + 4);
#pragma unroll
                        for (int j = 0; j < 4; ++j) { float ka, lf; const float lba = lb0[j], lbb = lb1[j];
                            fgate(v0[j], lba, ka, lf); v0[j] = ka; l0[j] = lf; fgate(v1[j], lbb, ka, lf); v1[j] = ka; l1[j] = lf; }
                        float* lp = LOGF + (size_t)row * 512 + (col0 + bj * HALF - 512); *(f32x4*)lp = l0; *(f32x4*)(lp + 4) = l1; }
                    u32x4 w; w.x = cvt_pk_bf16(v0[0], v0[1]); w.y = cvt_pk_bf16(v0[2], v0[3]); w.z = cvt_pk_bf16(v1[0], v1[1]); w.w = cvt_pk_bf16(v1[2], v1[3]);
                    *(u32x4*)(rowp + bj * HALF) = w; } }
    }
};
struct EpiU {
    static constexpr bool PERM = true, AFTER_DRAIN = false, HAS_NOSTORE = false;
    bf16_t* U; const float* SS; int ldu;
    __device__ __forceinline__ void operator()(const f32x4 (&acc)[2][2][4][2], const Unit& u, int wr, int wc, int fr, int fq) const {
        const int row0 = u.pm * BM + wr * 64 + fr, col0 = u.pn * BM + wc * 32 + 8 * fq;
#pragma unroll
        for (int ai = 0; ai < 2; ++ai)
#pragma unroll
            for (int m = 0; m < 4; ++m) { const int row = row0 + ai * HALF + m * 16; const float r = row_rstd(SS, row); bf16_t* rowp = U + (size_t)row * ldu + col0;
#pragma unroll
                for (int bj = 0; bj < 2; ++bj) { const f32x4 v0 = acc[ai][bj][m][0] * r, v1 = acc[ai][bj][m][1] * r;
                    u32x4 w; w.x = cvt_pk_bf16(v0[0], v0[1]); w.y = cvt_pk_bf16(v0[2], v0[3]); w.z = cvt_pk_bf16(v1[0], v1[1]); w.w = cvt_pk_bf16(v1[2], v1[3]);
                    *(u32x4*)(rowp + bj * HALF) = w; }
                asm volatile("" ::: "memory"); }
    }
};

struct EpiUF {
    static constexpr bool PERM = true, AFTER_DRAIN = false, HAS_NOSTORE = false;
    bf16_t* HF; float* UH; const float* SS; const float* cw; const float* cb; PG8_LAS float* halo;
    __device__ __forceinline__ float rstd_fast(int row) const { const unsigned o = (unsigned)row * 32u; const f32x4 a = *(const f32x4*)((const char*)SS + o), b = *(const f32x4*)((const char*)SS + o + 16);
        return __builtin_amdgcn_rsqf((((a[0] + a[1]) + (a[2] + a[3])) + ((b[0] + b[1]) + (b[2] + b[3]))) * (1.0f / 2048.0f) + 1e-6f); }
    template <int CTRL> static __device__ __forceinline__ float dpp(float old, float x) { return __builtin_bit_cast(float, __builtin_amdgcn_update_dpp(__builtin_bit_cast(int, old), __builtin_bit_cast(int, x), CTRL, 0xf, 0xf, false)); }
    template <int CTRL> static __device__ __forceinline__ float dppz(float x) { return __builtin_bit_cast(float, __builtin_amdgcn_update_dpp(0, __builtin_bit_cast(int, x), CTRL, 0xf, 0xf, true)); }
    __device__ __forceinline__ float gelu(float x) const { const float t = 0.7978845608028654f * (x + 0.044715f * x * x * x); return x * __builtin_amdgcn_rcpf(1.0f + __builtin_amdgcn_exp2f(-2.8853900817779268f * t)); }
    __device__ __forceinline__ void operator()(const f32x4 (&acc)[2][2][4][2], const Unit& u, int wr_, int wc_, int fr_, int fq_) const {
        const int tid_ = (int)opq_u32(threadIdx.x), wid_ = __builtin_amdgcn_readfirstlane(tid_ >> 6), wr = wid_ >> 2, wc = wid_ & 3, fr = tid_ & 15, fq = (tid_ >> 4) & 3;
                const int row0 = u.pm * BM + wr * 64 + fr, ct0 = wc * 32 + 8 * fq;
        float* uh = UH + (size_t)(u.pm * 44 + u.pn) * 1024;
        { const float r00 = rstd_fast(row0);
#pragma unroll
        for (int ai = 0; ai < 2; ++ai) { const float r3 = rstd_fast(row0 + ai * HALF + 48);
#pragma unroll
            for (int bj = 0; bj < 2; ++bj)
#pragma unroll
                for (int n = 0; n < 2; ++n) { const int ct = bj * HALF + ct0 + 4 * n;
                    if (fr >= 14) { const f32x4 v = acc[ai][bj][3][n] * r3; *(PG8_LAS f32x4*)(halo + ((2 * ai + wr) * 2 + (fr - 14)) * 256 + ct) = v;
                        if (ai == 1 && wr == 1) *(f32x4*)(uh + (2 + fr - 14) * 256 + ct) = v; }
                    if (fr < 2 && ai == 0 && wr == 0) *(f32x4*)(uh + fr * 256 + ct) = acc[0][bj][0][n] * r00; } } }
        PG8_LAS float* WL = halo + 2048; PG8_LAS float* RSL = halo + 3072;
#pragma unroll
        for (int q = 0; q < 2; ++q) { const int idx = tid_ + 512 * q, kind = idx >> 8, ct = idx & 255, col = (ct >> 7) * 5632 + u.pn * HALF + (ct & 127);
            WL[idx] = kind < 3 ? cw[kind * 11264 + col] : cb[col]; }
        if (tid_ < 256) RSL[tid_] = rstd_fast(u.pm * BM + tid_);
        asm volatile("s_waitcnt vmcnt(0) lgkmcnt(0)" ::: "memory"); __builtin_amdgcn_s_barrier(); asm volatile("" ::: "memory");
#pragma unroll
        for (int ai = 0; ai < 2; ++ai) { const int k = 2 * ai + wr;
            __builtin_amdgcn_sched_barrier(0);
            float rs4[4];
#pragma unroll
            for (int m = 0; m < 4; ++m) rs4[m] = RSL[ai * HALF + wr * 64 + m * 16 + fr];
            __builtin_amdgcn_sched_barrier(0);
            unsigned outp[4][4];
#pragma unroll
            for (int n = 0; n < 2; ++n) {
                float val[4][4];
#pragma unroll
                for (int bj = 1; bj >= 0; --bj) {
                    const int wo = bj * HALF + ct0 + 4 * n;
                    const f32x4 W0 = *(const PG8_LAS f32x4*)(WL + wo), W1 = *(const PG8_LAS f32x4*)(WL + 256 + wo), W2 = *(const PG8_LAS f32x4*)(WL + 512 + wo), Bv = *(const PG8_LAS f32x4*)(WL + 768 + wo);
                    f32x4 h0 = (f32x4){0.f, 0.f, 0.f, 0.f}, h1 = h0;
                    if (k > 0) { h0 = *(const PG8_LAS f32x4*)(halo + ((k - 1) * 2 + 0) * 256 + bj * HALF + ct0 + 4 * n); h1 = *(const PG8_LAS f32x4*)(halo + ((k - 1) * 2 + 1) * 256 + bj * HALF + ct0 + 4 * n); }
#pragma unroll
                    for (int j = 0; j < 4; ++j) { float c1 = h1[j], c2 = fr == 0 ? h0[j] : h1[j]; float ge[4];
#pragma unroll
                        for (int m = 0; m < 4; ++m) { const float um = acc[ai][bj][m][n][j] * rs4[m];
                            const float p1 = dpp<0x111>(c1, um), p2 = dpp<0x112>(c2, um);
                            const float cv = Bv[j] + W0[j] * p2 + W1[j] * p1 + W2[j] * um;
                            c1 = dppz<0x10F>(um); c2 = dppz<0x10E>(um);
                            if (bj == 1) val[m][j] = cv; else ge[m] = gelu(cv) * val[m][j]; }
                        if (bj == 0) {
#pragma unroll
                            for (int m = 0; m < 4; ++m) { if (j & 1) outp[m][2 * n + (j >> 1)] = cvt_pk_bf16(val[m][j - 1], ge[m]); else val[m][j] = ge[m]; } }
                        __builtin_amdgcn_sched_barrier(0); } } }
#pragma unroll
            for (int m = 0; m < 4; ++m) { u32x4 w; w.x = outp[m][0]; w.y = outp[m][1]; w.z = outp[m][2]; w.w = outp[m][3];
                *(u32x4*)((char*)HF + ((unsigned)(row0 + ai * HALF + m * 16) * 5632u + (unsigned)(u.pn * HALF + ct0)) * 2u) = w; } }
    }
};
struct EpiRes {
    static constexpr bool PERM = true, AFTER_DRAIN = true, HAS_NOSTORE = false;
    const float* XR; const bf16_t* XBi; bf16_t* XB; float* SSo;
    __device__ __forceinline__ void fused(const f32x4 (&acc)[2][2][4][2], const Unit& u, int wr, int wc, int fr, int fq, PG8_LAS unsigned char* lds, int wid, int lane) const {
        PG8_LAS float* P = (PG8_LAS float*)lds;
        const int row0 = u.pm * BM + wr * 64 + fr, col0 = u.pn * BM + wc * 32 + 8 * fq;
#pragma unroll
        for (int ai = 0; ai < 2; ++ai)
#pragma unroll
        for (int mh = 0; mh < 1; ++mh) {
            u32x4 ra[4][2], rb[4][2];
#pragma unroll
            for (int mm = 0; mm < 4; ++mm) { const size_t off = (size_t)(row0 + ai * HALF + mm * 16) * 2048 + col0;
#pragma unroll
                for (int bj = 0; bj < 2; ++bj) { if (XR) { ra[mm][bj] = *(const u32x4*)(XR + off + bj * HALF); rb[mm][bj] = *(const u32x4*)(XR + off + bj * HALF + 4); }
                    else { ra[mm][bj] = *(const u32x4*)(XBi + off + bj * HALF); rb[mm][bj] = ra[mm][bj]; } } }
#pragma unroll
            for (int mm = 0; mm < 4; ++mm) { const int m = mm; const size_t off = (size_t)(row0 + ai * HALF + m * 16) * 2048 + col0; float q = 0.f;
#pragma unroll
                for (int bj = 0; bj < 2; ++bj) { f32x4 x0, x1;
                    if (XR) { x0 = __builtin_bit_cast(f32x4, ra[mm][bj]); x1 = __builtin_bit_cast(f32x4, rb[mm][bj]); }
                    else { const u32x4 h = ra[mm][bj];
                        x0[0] = __uint_as_float(h.x << 16); x0[1] = __uint_as_float(h.x & 0xffff0000u); x0[2] = __uint_as_float(h.y << 16); x0[3] = __uint_as_float(h.y & 0xffff0000u);
                        x1[0] = __uint_as_float(h.z << 16); x1[1] = __uint_as_float(h.z & 0xffff0000u); x1[2] = __uint_as_float(h.w << 16); x1[3] = __uint_as_float(h.w & 0xffff0000u); }
                    const f32x4 v0 = x0 + acc[ai][bj][m][0], v1 = x1 + acc[ai][bj][m][1];
                    u32x4 w; w.x = cvt_pk_bf16(v0[0], v0[1]); w.y = cvt_pk_bf16(v0[2], v0[3]); w.z = cvt_pk_bf16(v1[0], v1[1]); w.w = cvt_pk_bf16(v1[2], v1[3]);
                    *(u32x4*)(XB + off + bj * HALF) = w;
                    q += ((v0[0] * v0[0] + v0[1] * v0[1]) + (v0[2] * v0[2] + v0[3] * v0[3])) + ((v1[0] * v1[0] + v1[1] * v1[1]) + (v1[2] * v1[2] + v1[3] * v1[3])); }
                q += __shfl_xor(q, 16); q += __shfl_xor(q, 32);
                if (fq == 0) P[(ai * HALF + wr * 64 + m * 16 + fr) * 4 + wc] = q; }
            asm volatile("" ::: "memory"); }
        asm volatile("s_waitcnt lgkmcnt(0)" ::: "memory"); __builtin_amdgcn_s_barrier(); asm volatile("" ::: "memory");
        const int t = wid * 64 + lane;
        if (t < 256) { const PG8_LAS f32x4* p4 = (const PG8_LAS f32x4*)P; const f32x4 a = p4[t]; SSo[(size_t)(u.pm * BM + t) * 8 + u.pn] = (a[0] + a[1]) + (a[2] + a[3]); }
        asm volatile("s_waitcnt lgkmcnt(0)" ::: "memory"); __builtin_amdgcn_s_barrier(); asm volatile("" ::: "memory");
    }
};
template <class Epi, class Sched, bool ALIGN_EPI = false, bool SP2 = false>
__device__ __forceinline__ void gemm_phase(PG8_LAS unsigned char* lds, const Gemm g, const Sched& S, const Epi& E) {
    const int tid = (int)opq_u32(threadIdx.x), wid = __builtin_amdgcn_readfirstlane(tid >> 6), lane = tid & 63, wr = wid >> 2, wc = wid & 3, fr = lane & 15, fq = lane >> 4;
    const int K = g.K, nt = K / BK;
    unsigned voffA[2], voffB[2];
#pragma unroll
    for (int i = 0; i < 2; ++i) { int R, C; stage_rc(tid * 16 + i * 8192, R, C); const int Rb = Epi::PERM ? ((R & ~31) + perm32(R & 31)) : R;
        voffA[i] = (unsigned)(R * K + C) * 2u; voffB[i] = (unsigned)(Rb * K + C) * 2u; }
    const size_t kstep = (size_t)(BK * 2);
    const size_t hstep = (size_t)HALF * K * 2;
    const size_t tstep = 2 * hstep;
    const unsigned ldsw = (unsigned)wid * 1024u;
    const int aoff = lds_byte(wr * 64 + fr, fq * 8), boff = lds_byte(wc * 32 + fr, fq * 8);
#define PG8_SA(b, h) (((b) * 2 + (h)) * HTB)
#define PG8_SB(b, h) ((4 + (b) * 2 + (h)) * HTB)
#define PG8_STAGE(bufoff, gbase, voff) do { _Pragma("unroll") for (int _i = 0; _i < 2; ++_i) \
        __builtin_amdgcn_global_load_lds((const unsigned*)((const char*)(gbase) + (voff)[_i]), (PG8_LAS unsigned*)(lds + (bufoff) + ldsw + _i * 8192), 16, 0, 0); } while (0)
#define PG8_LDA(dst, b, h) do { _Pragma("unroll") for (int m = 0; m < 4; ++m) _Pragma("unroll") for (int k = 0; k < 2; ++k) dst[m][k] = *(const PG8_LAS bf16x8*)(lds + PG8_SA(b, h) + aoff + m * 2048 + k * 1024); } while (0)
#define PG8_LDB(dst, b, h) do { _Pragma("unroll") for (int n = 0; n < 2; ++n) _Pragma("unroll") for (int k = 0; k < 2; ++k) dst[n][k] = *(const PG8_LAS bf16x8*)(lds + PG8_SB(b, h) + boff + n * 2048 + k * 1024); } while (0)
#define PG8_MMA(ai, bj, At, Bt) do { __builtin_amdgcn_s_setprio(1); _Pragma("unroll") for (int m = 0; m < 4; ++m) _Pragma("unroll") for (int n = 0; n < 2; ++n) _Pragma("unroll") for (int k = 0; k < 2; ++k) \
        acc[ai][bj][m][n] = __builtin_amdgcn_mfma_f32_16x16x32_bf16(Bt[n][k], At[m][k], acc[ai][bj][m][n], 0, 0, 0); __builtin_amdgcn_s_setprio(0); } while (0)
#define PG8_WAIT_V(n) asm volatile("s_waitcnt vmcnt(" #n ")" ::: "memory")
#define PG8_WAIT_L(n) asm volatile("s_waitcnt lgkmcnt(" #n ")" ::: "memory")
#define PG8_BAR __builtin_amdgcn_s_barrier()
#define PG8_SCHED __builtin_amdgcn_sched_barrier(0)
    Unit cur, nxt; int ui = 0;
    if (!S.next(0, cur)) return;
    f32x4 acc[2][2][4][2];
#pragma unroll
    for (int a = 0; a < 2; ++a)
#pragma unroll
        for (int b = 0; b < 2; ++b)
#pragma unroll
            for (int m = 0; m < 4; ++m)
#pragma unroll
                for (int n = 0; n < 2; ++n) acc[a][b][m][n] = (f32x4){0.f, 0.f, 0.f, 0.f};
    bf16x8 At[4][2], B0[2][2], B1[2][2];
    const char* cA = (const char*)g.A + (size_t)cur.pm * tstep; const char* cB = (const char*)g.Bt + (size_t)cur.pn * tstep;
    S.a_ready(cur);
    if constexpr (SP2) {
        PG8_STAGE(PG8_SB(0, 0), cB, voffB); PG8_STAGE(PG8_SB(0, 1), cB + hstep, voffB); PG8_STAGE(PG8_SA(0, 0), cA, voffA); PG8_STAGE(PG8_SA(0, 1), cA + hstep, voffA);
        if (wr == 1) PG8_BAR;
        PG8_WAIT_V(2); PG8_BAR;
        PG8_STAGE(PG8_SB(1, 0), cB + kstep, voffB); PG8_STAGE(PG8_SA(1, 0), cA + kstep, voffA); PG8_STAGE(PG8_SB(1, 1), cB + hstep + kstep, voffB);
        PG8_WAIT_V(6); PG8_BAR;
    } else {
        PG8_STAGE(PG8_SB(0, 0), cB, voffB); PG8_STAGE(PG8_SA(0, 0), cA, voffA); PG8_STAGE(PG8_SB(0, 1), cB + hstep, voffB); PG8_STAGE(PG8_SA(0, 1), cA + hstep, voffA);
        if (wr == 1) PG8_BAR;
        PG8_WAIT_V(4); PG8_BAR;
        PG8_STAGE(PG8_SB(1, 0), cB + kstep, voffB); PG8_STAGE(PG8_SA(1, 0), cA + kstep, voffA); PG8_STAGE(PG8_SB(1, 1), cB + hstep + kstep, voffB);
        PG8_WAIT_V(6); PG8_BAR;
    }
    for (;;) {
        const bool has_next = S.next(ui + 1, nxt);
        const char* nA = has_next ? (const char*)g.A + (size_t)nxt.pm * tstep : cA; const char* nB = has_next ? (const char*)g.Bt + (size_t)nxt.pn * tstep : cB;
        for (int t = 0; t < nt; t += 2) {
            const bool last = (t == nt - 2);
            const char* a1 = cA + (size_t)(t + 1) * kstep;
            const char* a2 = last ? nA : cA + (size_t)(t + 2) * kstep; const char* b2 = last ? nB : cB + (size_t)(t + 2) * kstep;
            const char* a3 = a2 + kstep; const char* b3 = b2 + kstep;
            if (last && has_next) S.a_ready(nxt);
            if constexpr (SP2) {
            PG8_LDB(B0, 0, 0); PG8_LDB(B1, 0, 1); PG8_SCHED; PG8_LDA(At, 0, 0); PG8_STAGE(PG8_SA(1, 1), a1 + hstep, voffA);
            PG8_WAIT_V(8); PG8_WAIT_L(0); PG8_BAR; PG8_MMA(0, 0, At, B0); PG8_MMA(0, 1, At, B1); PG8_BAR; PG8_SCHED;
            PG8_LDA(At, 0, 1); PG8_STAGE(PG8_SB(0, 0), b2, voffB); PG8_STAGE(PG8_SB(0, 1), b2 + hstep, voffB); PG8_STAGE(PG8_SA(0, 0), a2, voffA);
            PG8_WAIT_V(8); PG8_WAIT_L(0); PG8_BAR; PG8_MMA(1, 0, At, B0); PG8_MMA(1, 1, At, B1); PG8_BAR; PG8_SCHED;
            PG8_LDB(B0, 1, 0); PG8_LDB(B1, 1, 1); PG8_SCHED; PG8_LDA(At, 1, 0); PG8_STAGE(PG8_SA(0, 1), a2 + hstep, voffA);
            PG8_WAIT_V(8); PG8_WAIT_L(0); PG8_BAR; PG8_MMA(0, 0, At, B0); PG8_MMA(0, 1, At, B1); PG8_BAR; PG8_SCHED;
            PG8_LDA(At, 1, 1); PG8_STAGE(PG8_SB(1, 0), b3, voffB); PG8_STAGE(PG8_SB(1, 1), b3 + hstep, voffB); PG8_STAGE(PG8_SA(1, 0), a3, voffA);
            PG8_WAIT_V(8); PG8_WAIT_L(0); PG8_BAR; PG8_MMA(1, 0, At, B0); PG8_MMA(1, 1, At, B1); PG8_BAR; PG8_SCHED;
            } else {
            PG8_LDB(B0, 0, 0); PG8_SCHED; PG8_LDA(At, 0, 0); PG8_STAGE(PG8_SA(1, 1), a1 + hstep, voffA);
            PG8_WAIT_L(8); PG8_BAR; PG8_WAIT_L(0); PG8_MMA(0, 0, At, B0); PG8_BAR; PG8_SCHED;
            PG8_LDB(B1, 0, 1); PG8_STAGE(PG8_SB(0, 0), b2, voffB);
            PG8_BAR; PG8_WAIT_L(0); PG8_MMA(0, 1, At, B1); PG8_BAR;
            PG8_LDA(At, 0, 1); PG8_STAGE(PG8_SA(0, 0), a2, voffA);
            PG8_BAR; PG8_WAIT_L(0); PG8_MMA(1, 0, At, B0); PG8_BAR; PG8_SCHED;
            PG8_STAGE(PG8_SB(0, 1), b2 + hstep, voffB);
            PG8_WAIT_V(6); PG8_BAR; PG8_MMA(1, 1, At, B1); PG8_BAR;
            PG8_LDB(B0, 1, 0); PG8_SCHED; PG8_LDA(At, 1, 0); PG8_STAGE(PG8_SA(0, 1), a2 + hstep, voffA);
            PG8_WAIT_L(8); PG8_BAR; PG8_WAIT_L(0); PG8_MMA(0, 0, At, B0); PG8_BAR; PG8_SCHED;
            PG8_LDB(B1, 1, 1); PG8_STAGE(PG8_SB(1, 0), b3, voffB);
            PG8_BAR; PG8_WAIT_L(0); PG8_MMA(0, 1, At, B1); PG8_BAR;
            PG8_LDA(At, 1, 1); PG8_STAGE(PG8_SA(1, 0), a3, voffA);
            PG8_BAR; PG8_WAIT_L(0); PG8_MMA(1, 0, At, B0); PG8_BAR; PG8_SCHED;
            PG8_STAGE(PG8_SB(1, 1), b3 + hstep, voffB);
            PG8_WAIT_V(6); PG8_BAR; PG8_MMA(1, 1, At, B1); PG8_BAR;
            }
        }
        if constexpr (ALIGN_EPI) { if (wr == 0) PG8_BAR; }
        if constexpr (!Epi::AFTER_DRAIN) { E(acc, cur, wr, wc, fr, fq);
#ifdef REP_EPI
            asm volatile("" ::: "memory"); E(acc, cur, wr, wc, fr, fq);
#endif
#ifdef REP_EPI_NOSTORE
            if constexpr (Epi::HAS_NOSTORE) { asm volatile("" ::: "memory"); Epi E2 = E; E2.Z = (decltype(E2.Z))opq_u64(0); E2(acc, cur, wr, wc, fr, fq); }
#endif
            S.done(cur); }
        if (!has_next) break;
#pragma unroll
        for (int a = 0; a < 2; ++a)
#pragma unroll
            for (int b = 0; b < 2; ++b)
#pragma unroll
                for (int m = 0; m < 4; ++m)
#pragma unroll
                    for (int n = 0; n < 2; ++n) acc[a][b][m][n] = (f32x4){0.f, 0.f, 0.f, 0.f};
        cur = nxt; cA = nA; cB = nB; ++ui;
        if constexpr (ALIGN_EPI) { if (wr == 1) PG8_BAR; }
    }
    PG8_WAIT_V(0);
    if constexpr (!ALIGN_EPI) { if (wr == 0) PG8_BAR; }
    PG8_BAR;
    if constexpr (Epi::AFTER_DRAIN) { E.fused(acc, cur, wr, wc, fr, fq, lds, wid, lane); S.done(cur); }
#undef PG8_SA
#undef PG8_SB
#undef PG8_STAGE
#undef PG8_LDA
#undef PG8_LDB
#undef PG8_MMA
#undef PG8_WAIT_V
#undef PG8_WAIT_L
#undef PG8_BAR
#undef PG8_SCHED
}
}
#define GAS __attribute__((address_space(1)))
#define LAS __attribute__((address_space(3)))
namespace mk {
using namespace cfg;
typedef unsigned short bf16;
typedef float f32x4 __attribute__((ext_vector_type(4)));
typedef float f32x2 __attribute__((ext_vector_type(2)));
typedef float f32x16 __attribute__((ext_vector_type(16)));
typedef short bf16x8 __attribute__((ext_vector_type(8)));
typedef short s16x4 __attribute__((ext_vector_type(4)));
typedef unsigned u32x4 __attribute__((ext_vector_type(4)));
typedef unsigned u32x2 __attribute__((ext_vector_type(2)));
constexpr int NWAVES = 8, NTHR = 512;
constexpr int LDS_BYTES = 163840;
constexpr int MISC_OFF = 163840 - 1024;
constexpr float LOG2E = 1.4426950408889634f;

#define LDS_WAIT() asm volatile("s_waitcnt lgkmcnt(0)" ::: "memory")
#define VM_WAIT() asm volatile("s_waitcnt vmcnt(0)" ::: "memory")
#define WG_BAR() do { asm volatile("s_waitcnt lgkmcnt(0)" ::: "memory"); __builtin_amdgcn_s_barrier(); asm volatile("" ::: "memory"); } while (0)
__device__ __forceinline__ unsigned pk2(float lo, float hi) { unsigned r; asm volatile("v_cvt_pk_bf16_f32 %0, %1, %2" : "=v"(r) : "v"(lo), "v"(hi)); return r; }
__device__ __forceinline__ float bf2f(unsigned short b) { return __uint_as_float(((unsigned)b) << 16); }
__device__ __forceinline__ float bflo(unsigned w) { return __uint_as_float(w << 16); }
__device__ __forceinline__ float bfhi(unsigned w) { return __uint_as_float(w & 0xffff0000u); }
__device__ __forceinline__ float wave_sum(float v) {
#pragma unroll
    for (int o = 1; o < 64; o <<= 1) v += __shfl_xor(v, o);
    return v;
}
__device__ __forceinline__ float wave_max(float v) {
#pragma unroll
    for (int o = 1; o < 64; o <<= 1) v = fmaxf(v, __shfl_xor(v, o));
    return v;
}
__device__ __forceinline__ float fexp2(float x) { return __builtin_amdgcn_exp2f(x); }
__device__ __forceinline__ float frcp(float x) { return __builtin_amdgcn_rcpf(x); }
__device__ __forceinline__ float silu(float x) { return x * frcp(1.0f + fexp2(-LOG2E * x)); }
__device__ __forceinline__ float gelu_tanh(float x) {
    const float u = 0.7978845608028654f * (x + 0.044715f * x * x * x);
    return x * frcp(1.0f + fexp2(-2.0f * LOG2E * u));
}
__device__ __forceinline__ unsigned off_b(unsigned row, unsigned ch) { return 256u * row + 16u * (ch ^ (((row & 3) << 2) | ((row >> 2) & 3))); }
__device__ __forceinline__ unsigned row_read_addr_16(unsigned lane, unsigned rb, unsigned s) { return off_b((lane & 15) + 16 * rb, 4 * s + (lane >> 4)); }
__device__ __forceinline__ unsigned tr_addr(unsigned lane, unsigned r0, unsigned c) { const unsigned q = (lane & 15) >> 2, p = lane & 3; return off_b(r0 + q, 2 * c + (p >> 1)) + 8 * (p & 1); }
__device__ __forceinline__ s16x4 tr_read(const LAS unsigned char* base, unsigned off) {
    typedef short v4i16 __attribute__((ext_vector_type(4)));
    return __builtin_bit_cast(s16x4, __builtin_amdgcn_ds_read_tr16_b64_v4i16((LAS v4i16*)(base + off)));
}
__device__ __forceinline__ bf16x8 cat8(s16x4 lo, s16x4 hi) { return __builtin_shufflevector(lo, hi, 0, 1, 2, 3, 4, 5, 6, 7); }
__device__ __forceinline__ bf16x8 lds_frag(const LAS unsigned char* base, unsigned off) { return *(const LAS bf16x8*)(base + off); }
#define MFMA16(a, b, c) __builtin_amdgcn_mfma_f32_16x16x32_bf16((a), (b), (c), 0, 0, 0)
#define MFMA32(a, b, c) __builtin_amdgcn_mfma_f32_32x32x16_bf16((a), (b), (c), 0, 0, 0)
__device__ __forceinline__ bf16x8 pack8(const f32x4& a, const f32x4& b) {
    u32x4 w; w.x = pk2(a[0], a[1]); w.y = pk2(a[2], a[3]); w.z = pk2(b[0], b[1]); w.w = pk2(b[2], b[3]); return __builtin_bit_cast(bf16x8, w);
}

constexpr size_t MiB = 1u << 20;
constexpr size_t WS_CTL = 0, CTL_ZERO_BYTES = 1 * MiB;
constexpr size_t SZ_WIN = (size_t)NCOL * DM * 2, SZ_WOUT = (size_t)DM * DM * 2, SZ_WUP = (size_t)NUP * DM * 2, SZ_WDN = (size_t)DM * DFF * 2;
constexpr size_t WS_WIN = 1 * MiB, WS_WOUT = WS_WIN + 2 * SZ_WIN, WS_WUP = WS_WOUT + 2 * SZ_WOUT, WS_WDN = WS_WUP + 2 * SZ_WUP;
constexpr size_t WS_X = WS_WDN + 2 * SZ_WDN;
constexpr size_t WS_XB = WS_X + (size_t)MP * DM * 4;
constexpr size_t WS_SS = WS_XB + (size_t)MP * DM * 2;
constexpr size_t WS_Z = WS_SS + (size_t)MP * 8 * 4;
constexpr size_t WS_HF = WS_Z;
constexpr size_t WS_LOGF = WS_Z + (size_t)MP * NCOL * 2;
constexpr size_t WS_MIX = WS_LOGF + (size_t)MP * 512 * 4;
constexpr size_t WS_U = WS_MIX + (size_t)MP * DM * 2;
constexpr size_t WS_XS = WS_U + (size_t)MP * NUP * 2;
constexpr size_t WS_XSB = WS_XS + (size_t)DB * DM * 4;
constexpr size_t WS_ZS = WS_XSB + (size_t)DB * DM * 2;
constexpr size_t WS_MIXS = WS_ZS + (size_t)DB * NCOL * 4;
constexpr size_t WS_US = WS_MIXS + (size_t)DB * DM * 2;
constexpr size_t WS_HFS = WS_US + (size_t)DB * NUP * 4;
constexpr size_t WS_END = WS_HFS + (size_t)DB * DFF * 2;
static_assert(WS_END <= (size_t)700 * MiB, "workspace map");
constexpr int CW_TMO = 0, CW_BAR = 4096, CW_SUB = 8192;
#define XB_TMO      128
#define XB_XCNT(j)  (256  + 64 * (j))
#define XB_XSUB(j)  (1280 + 64 * (j))
#define XB_XGEN(j)  (2304 + 64 * (j))
#define XB_TOP      3328
#define XB_TOPGEN   3392
#define XCD_BAR_WORDS 3456
#define XB_SPIN_CAP (1u << 18)

__device__ __forceinline__ unsigned xb_ld(unsigned* p)              { return __hip_atomic_load(p, __ATOMIC_RELAXED, __HIP_MEMORY_SCOPE_AGENT); }
__device__ __forceinline__ unsigned xb_add(unsigned* p, unsigned v) { return __hip_atomic_fetch_add(p, v, __ATOMIC_RELAXED, __HIP_MEMORY_SCOPE_AGENT); }
__device__ __forceinline__ unsigned xb_xcc_id() { return (unsigned)__builtin_amdgcn_s_getreg((3 << 11) | 20) & 0xFu; }
#define XB_SPIN(cond, bar) do { unsigned _sp = 0; while (cond) { __builtin_amdgcn_s_sleep(1); \
    if ((++_sp & 255u) == 0u) { if (xb_ld(&(bar)[XB_TMO])) break; if (_sp > XB_SPIN_CAP) { atomicAdd(&(bar)[XB_TMO], 1u); break; } } } } while (0)

struct XcdBarrier {
    unsigned* bar; unsigned x;
    volatile LAS unsigned* st;
};

__device__ __forceinline__ XcdBarrier xcd_barrier_post(unsigned* bar, volatile LAS unsigned* st) {
    XcdBarrier b; b.bar = bar; b.x = xb_xcc_id(); b.st = st;
    if (threadIdx.x == 0) (void)xb_add(&bar[XB_XCNT(b.x)], 1u);
    return b;
}
__device__ __forceinline__ void xcd_barrier_complete(unsigned* bar, unsigned x, unsigned& nloc, unsigned& nx) {
    const unsigned G = gridDim.x * gridDim.y * gridDim.z;
    unsigned sum, cnt, mine, sp = 0u;
    for (;;) {
        sum = 0u; cnt = 0u; mine = 0u;
#pragma unroll
        for (unsigned j = 0; j < 16; ++j) { const unsigned c = xb_ld(&bar[XB_XCNT(j)]); sum += c; cnt += (c > 0u) ? 1u : 0u; mine = (j == x) ? c : mine; }
        if (sum == G) break;
        __builtin_amdgcn_s_sleep(1);
        if ((++sp & 255u) == 0u) { if (xb_ld(&bar[XB_TMO])) break; if (sp > XB_SPIN_CAP) { atomicAdd(&bar[XB_TMO], 1u); break; } }
    }
    nloc = mine > 0u ? mine : 1u; nx = cnt > 0u ? cnt : 1u;
}

__device__ __forceinline__ void xcd_barrier(const XcdBarrier& b) {
    asm volatile("s_waitcnt vmcnt(0)" ::: "memory");
    __syncthreads();
    if (threadIdx.x == 0) {
        unsigned* bar = b.bar;
        __builtin_amdgcn_s_waitcnt(0);
        unsigned nloc = b.st[0], nx = b.st[1];
        if (nloc == 0u) { xcd_barrier_complete(bar, b.x, nloc, nx); b.st[0] = nloc; b.st[1] = nx; }
        const unsigned old = xb_add(&bar[XB_XSUB(b.x)], 1u);
        const unsigned gen = old / nloc;
        if (old + 1u == (gen + 1u) * nloc) {
            __builtin_amdgcn_fence(__ATOMIC_RELEASE, "agent");
            asm volatile("s_waitcnt vmcnt(0)" ::: "memory");
            const unsigned og = xb_add(&bar[XB_TOP], 1u);
            const unsigned tg = og / nx;
            if (og + 1u == (tg + 1u) * nx) xb_add(&bar[XB_TOPGEN], 1u);
            else XB_SPIN(xb_ld(&bar[XB_TOPGEN]) == tg, bar);
            __builtin_amdgcn_fence(__ATOMIC_ACQUIRE, "agent");
            xb_add(&bar[XB_XGEN(b.x)], 1u);
            asm volatile("s_waitcnt vmcnt(0)" ::: "memory");
        } else {
            XB_SPIN(xb_ld(&bar[XB_XGEN(b.x)]) == gen, bar);
            __builtin_amdgcn_fence(__ATOMIC_ACQUIRE, "agent");
            asm volatile("s_waitcnt vmcnt(0)" ::: "memory");
        }
    }
    __syncthreads();
}

__device__ __forceinline__ void sub_barrier(unsigned* ctr, unsigned target, unsigned* tmo_bar) {
    asm volatile("s_waitcnt vmcnt(0)" ::: "memory");
    __syncthreads();
    if (threadIdx.x == 0) {
        __builtin_amdgcn_s_waitcnt(0);
        __builtin_amdgcn_fence(__ATOMIC_RELEASE, "agent");
        asm volatile("s_waitcnt vmcnt(0)" ::: "memory");
        (void)xb_add(ctr, 1u);
        XB_SPIN(xb_ld(ctr) < target, tmo_bar);
        __builtin_amdgcn_fence(__ATOMIC_ACQUIRE, "agent");
        asm volatile("s_waitcnt vmcnt(0)" ::: "memory");
    }
    __syncthreads();
}
struct Args { const float* in[20]; float* out; unsigned char* ws; int ph_lo, ph_hi; unsigned rep_mask, pad; };
struct Frame {
    LAS unsigned char* lds; int tid, lane, wave, G, vcu, bid;
    unsigned char* ws; float* out;
    const float *x_prompt, *x_sample, *state_hgrn, *cache_k, *cache_v, *state_ret, *state_conv, *norm1, *w_in, *lbraw, *hgrn_g, *sinks, *ret_g, *w_out, *norm2, *w_up, *conv_w, *conv_b, *w_down, *fin_g;
};

struct P0Item { const float* W; bf16* WT; const float* gain; int K, N, k0, n0, r0; };
__device__ __forceinline__ void p0_item_load(const P0Item& it, f32x4 (&v)[16], int lane) {
    const int c4 = (lane & 15) * 4, kr = lane >> 4;
#pragma unroll
    for (int i = 0; i < 16; ++i) v[i] = *(const f32x4*)(it.W + (size_t)(it.k0 + 4 * i + kr) * it.N + it.n0 + c4);
}
__device__ __forceinline__ void p0_item_emit(const P0Item& it, const f32x4 (&v)[16], LAS float* scr, int lane) {
    const int c4 = (lane & 15) * 4, kr = lane >> 4;
#pragma unroll
    for (int i = 0; i < 16; ++i) { const int kk = 4 * i + kr; const float g = it.gain ? it.gain[it.k0 + kk] : 1.0f; LAS float* d = scr + kk * 65 + c4; d[0] = v[i][0] * g; d[1] = v[i][1] * g; d[2] = v[i][2] * g; d[3] = v[i][3] * g; }
    LDS_WAIT(); asm volatile("" ::: "memory");
    const int c = lane & 7;
#pragma unroll
    for (int j = 0; j < 8; ++j) { const int n = (lane >> 3) + 8 * j; const LAS float* s = scr + (8 * c) * 65 + n;
        u32x4 o; o.x = pk2(s[0 * 65], s[1 * 65]); o.y = pk2(s[2 * 65], s[3 * 65]); o.z = pk2(s[4 * 65], s[5 * 65]); o.w = pk2(s[6 * 65], s[7 * 65]);
        *(u32x4*)(it.WT + (size_t)(it.r0 + n) * it.K + it.k0 + 8 * c) = o; }
    LDS_WAIT(); asm volatile("" ::: "memory");
}
__device__ __forceinline__ float row_to_bf16(const float* xrow, bf16* orow, float* copy, int lane) {
    const f32x4* xr = (const f32x4*)xrow + lane; f32x4 v[8]; float s = 0.f;
#pragma unroll
    for (int j = 0; j < 8; ++j) { v[j] = xr[64 * j]; s += (v[j][0] * v[j][0] + v[j][1] * v[j][1]) + (v[j][2] * v[j][2] + v[j][3] * v[j][3]); }
    u32x2* o8 = (u32x2*)orow + lane;
#pragma unroll
    for (int j = 0; j < 8; ++j) { u32x2 w; w.x = pk2(v[j][0], v[j][1]); w.y = pk2(v[j][2], v[j][3]); o8[64 * j] = w; if (copy) ((f32x4*)copy + lane)[64 * j] = v[j]; }
    return wave_sum(s);
}
__device__ __forceinline__ void p0_prologue(Frame& F) {
    LAS float* scr = (LAS float*)(F.lds + F.wave * 17408);
    const int gw = F.vcu * NWAVES + F.wave, NGW = F.G * NWAVES;
    constexpr int I_IN = (DM / 64) * (NCOL / 64), I_OUT = (DM / 64) * (DM / 64), I_UP = (DM / 64) * (NUP / 64), I_DN = (DFF / 64) * (DM / 64), I_L = I_IN + I_OUT + I_UP + I_DN;
    auto describe = [&](int itx, P0Item& d) { const int l = itx / I_L; int r = itx % I_L; bool perm = false;
        if (r < I_IN) { d.W = F.w_in + (size_t)l * DM * NCOL; d.WT = (bf16*)(F.ws + WS_WIN + l * SZ_WIN); d.gain = F.norm1 + l * DM; d.K = DM; d.N = NCOL; }
        else if ((r -= I_IN) < I_OUT) { d.W = F.w_out + (size_t)l * DM * DM; d.WT = (bf16*)(F.ws + WS_WOUT + l * SZ_WOUT); d.gain = nullptr; d.K = DM; d.N = DM; }
        else if ((r -= I_OUT) < I_UP) { d.W = F.w_up + (size_t)l * DM * NUP; d.WT = (bf16*)(F.ws + WS_WUP + l * SZ_WUP); d.gain = F.norm2 + l * DM; d.K = DM; d.N = NUP; perm = true; }
        else { r -= I_UP; d.W = F.w_down + (size_t)l * DFF * DM; d.WT = (bf16*)(F.ws + WS_WDN + l * SZ_WDN); d.gain = nullptr; d.K = DFF; d.N = DM; }
        const int nblk = d.N / 64, kb = r / nblk, nb = r % nblk; d.k0 = 64 * kb; d.n0 = 64 * nb; d.r0 = d.n0;
        if (perm) { const int half = d.n0 >= DFF ? 1 : 0, np = d.n0 - half * DFF; d.r0 = 256 * (np >> 7) + 128 * half + (np & 127); } };
    { P0Item cur, nxt; f32x4 va[16], vb[16]; int it = gw;
      if (it < DEPTH * I_L) { describe(it, cur); p0_item_load(cur, va, F.lane); }
      while (it < DEPTH * I_L) { const int itn = it + NGW; const bool more = itn < DEPTH * I_L;
          if (more) { describe(itn, nxt); p0_item_load(nxt, vb, F.lane); }
          p0_item_emit(cur, va, scr, F.lane);
          if (more) { cur = nxt;
#pragma unroll
              for (int i = 0; i < 16; ++i) va[i] = vb[i]; }
          it = itn; } }
    float* SS = (float*)(F.ws + WS_SS);
    { f32x4 va[8], vb[8]; int m = gw;
      auto rowptr = [&](int mm) { return mm < MP ? F.x_prompt + (size_t)mm * DM : F.x_sample + (size_t)(mm - MP) * DM; };
      if (m < MP + DB) { const f32x4* xr = (const f32x4*)rowptr(m) + F.lane;
#pragma unroll
          for (int j = 0; j < 8; ++j) va[j] = xr[64 * j]; }
      while (m < MP + DB) { const int mn = m + NGW; const bool more = mn < MP + DB;
          if (more) { const f32x4* xr = (const f32x4*)rowptr(mn) + F.lane;
#pragma unroll
              for (int j = 0; j < 8; ++j) vb[j] = xr[64 * j]; }
          float s = 0.f;
#pragma unroll
          for (int j = 0; j < 8; ++j) s += (va[j][0] * va[j][0] + va[j][1] * va[j][1]) + (va[j][2] * va[j][2] + va[j][3] * va[j][3]);
          bf16* orow = m < MP ? (bf16*)(F.ws + WS_XB) + (size_t)m * DM : (bf16*)(F.ws + WS_XSB) + (size_t)(m - MP) * DM;
          u32x2* o8 = (u32x2*)orow + F.lane;
#pragma unroll
          for (int j = 0; j < 8; ++j) { u32x2 w; w.x = pk2(va[j][0], va[j][1]); w.y = pk2(va[j][2], va[j][3]); o8[64 * j] = w; if (m >= MP) ((f32x4*)((float*)(F.ws + WS_XS) + (size_t)(m - MP) * DM) + F.lane)[64 * j] = va[j]; }
          s = wave_sum(s);
          if (m < MP && F.lane < 8) SS[(size_t)m * 8 + F.lane] = F.lane == 0 ? s : 0.f;
          if (more) {
#pragma unroll
              for (int j = 0; j < 8; ++j) va[j] = vb[j]; }
          m = mn; } }
}

template <class Epi> __device__ __forceinline__ void small_gemm_unit(Frame& F, LAS float* red, const bf16* A, const bf16* Bt, int K, int n0, const Epi& E, int q0 = 0, int qs = 1) {
    const int lane = F.lane, r = lane & 15, g = lane >> 4, kw = K / 8, kbeg = F.wave * 64;
    const bf16* ap = A + (size_t)r * K + kbeg + 8 * g; const bf16* bp = Bt + (size_t)(n0 + r) * K + kbeg + 8 * g; const size_t half = (size_t)16 * K;
    f32x4 acc[2][2];
#pragma unroll
    for (int i = 0; i < 4; ++i) acc[i >> 1][i & 1] = (f32x4){0.f, 0.f, 0.f, 0.f};
    bf16x8 qa[4][2][2], qb[4][2][2]; const int nq = (kw / 64 - q0 + qs - 1) / qs;
#define SG_LOAD(s, q) do { _Pragma("unroll") for (int j = 0; j < 2; ++j) _Pragma("unroll") for (int e = 0; e < 2; ++e) { const int qe_ = q0 + (q) * qs; qa[s][j][e] = *(const bf16x8*)(ap + e * half + qe_ * 512 + 32 * j); qb[s][j][e] = *(const bf16x8*)(bp + e * half + qe_ * 512 + 32 * j); } \
        __builtin_amdgcn_sched_barrier(0); } while (0)
#define SG_MMA(s) do { _Pragma("unroll") for (int j = 0; j < 2; ++j) _Pragma("unroll") for (int e = 0; e < 2; ++e) _Pragma("unroll") for (int f = 0; f < 2; ++f) acc[e][f] = MFMA16(qa[s][j][e], qb[s][j][f], acc[e][f]); } while (0)
#pragma unroll
    for (int s_ = 0; s_ < 4; ++s_) if (s_ < nq) SG_LOAD(s_, s_);
#pragma unroll 1
    for (int q = 0; q < nq; q += 4) {
#pragma unroll
        for (int s_ = 0; s_ < 4; ++s_) if (q + s_ < nq) { SG_MMA(s_); if (q + s_ + 4 < nq) SG_LOAD(s_, q + s_ + 4); }
    }
#undef SG_LOAD
#undef SG_MMA
#pragma unroll
    for (int e = 0; e < 2; ++e)
#pragma unroll
        for (int f = 0; f < 2; ++f)
#pragma unroll
            for (int t = 0; t < 4; ++t) red[(F.wave * 32 + 16 * e + 4 * g + t) * 32 + 16 * f + r] = acc[e][f][t];
    LDS_WAIT(); __syncthreads();
    { const int row = F.tid >> 4, c2 = (F.tid & 15) * 2; float v0 = 0.f, v1 = 0.f;
#pragma unroll
      for (int w = 0; w < 8; ++w) { const f32x2 t = *(const LAS f32x2*)(red + (w * 32 + row) * 32 + c2); v0 += t.x; v1 += t.y; }
      E(row, n0 + c2, v0, v1); }
    LDS_WAIT(); __syncthreads();
}
__device__ __forceinline__ void sample_rstd(Frame& F, LAS float* rs) {
    const float* XS = (const float*)(F.ws + WS_XS);
    for (int i = 0; i < 4; ++i) { const int row = F.wave * 4 + i; const f32x4* xr = (const f32x4*)(XS + (size_t)row * DM) + F.lane; float s = 0.f; f32x4 v[8];
#pragma unroll
        for (int j = 0; j < 8; ++j) v[j] = xr[64 * j];
        asm volatile("" ::: "memory");
#pragma unroll
        for (int j = 0; j < 8; ++j) s += (v[j][0] * v[j][0] + v[j][1] * v[j][1]) + (v[j][2] * v[j][2] + v[j][3] * v[j][3]);
        s = wave_sum(s); if (F.lane == 0) rs[row] = 1.0f / sqrtf(s * (1.0f / DM) + EPS); }
    LDS_WAIT(); __syncthreads();
}
struct EpiS_scale { float* O; int ldo; const LAS float* rs; __device__ __forceinline__ void operator()(int row, int col, float v0, float v1) const { const float r = rs[row]; *(f32x2*)(O + (size_t)row * ldo + col) = (f32x2){v0 * r, v1 * r}; } };
struct EpiS_res { float* XS; bf16* XSB; __device__ __forceinline__ void operator()(int row, int col, float v0, float v1) const { float* p = XS + (size_t)row * DM + col; const f32x2 o = *(f32x2*)p; const float a = o.x + v0, b = o.y + v1; *(f32x2*)p = (f32x2){a, b}; *(unsigned*)(XSB + (size_t)row * DM + col) = pk2(a, b); } };
struct EpiS_part { float* P; __device__ __forceinline__ void operator()(int row, int col, float v0, float v1) const { *(f32x2*)(P + (size_t)row * DM + col) = (f32x2){v0, v1}; } };
constexpr size_t WS_PART = WS_END;
__device__ __forceinline__ void sample_kpart(Frame& F, int which, int layer, unsigned* ctr) {
    if (F.G != 256) return;
    const int u = F.bid & 63, ks = F.bid >> 6; EpiS_part E{(float*)(F.ws + WS_PART) + (size_t)ks * DB * DM};
    if (which == 2) small_gemm_unit(F, (LAS float*)F.lds, (const bf16*)(F.ws + WS_MIXS), (const bf16*)(F.ws + WS_WOUT + layer * SZ_WOUT), DM, 32 * u, E, ks, 4);
    else small_gemm_unit(F, (LAS float*)F.lds, (const bf16*)(F.ws + WS_HFS), (const bf16*)(F.ws + WS_WDN + layer * SZ_WDN), DFF, 32 * u, E, ks, 4);
    asm volatile("s_waitcnt vmcnt(0)" ::: "memory"); __syncthreads();
    if (threadIdx.x == 0) { __builtin_amdgcn_fence(__ATOMIC_RELEASE, "agent"); asm volatile("s_waitcnt vmcnt(0)" ::: "memory"); (void)xb_add(ctr, 1u); }
}
__device__ __forceinline__ void sample_kreduce(Frame& F, unsigned* ctr, unsigned* tmo_bar) {
    if (F.G != 256 || F.bid >= 64) return;
    if (threadIdx.x == 0) { XB_SPIN(xb_ld(ctr) < 256u, tmo_bar); __builtin_amdgcn_fence(__ATOMIC_ACQUIRE, "agent"); asm volatile("s_waitcnt vmcnt(0)" ::: "memory"); }
    __syncthreads();
    const int row = F.tid >> 4, col = 32 * F.bid + (F.tid & 15) * 2; const float* P = (const float*)(F.ws + WS_PART) + (size_t)row * DM + col;
    const f32x2 p0 = *(const f32x2*)P, p1 = *(const f32x2*)(P + (size_t)DB * DM), p2 = *(const f32x2*)(P + (size_t)2 * DB * DM), p3 = *(const f32x2*)(P + (size_t)3 * DB * DM);
    EpiS_res{(float*)(F.ws + WS_XS), (bf16*)(F.ws + WS_XSB)}(row, col, (p0.x + p1.x) + (p2.x + p3.x), (p0.y + p1.y) + (p2.y + p3.y));
}
__device__ __forceinline__ void sample_gemm_phase(Frame& F, int which, int layer, int wg_rank, int wg_count) {
    if (wg_rank < 0 || wg_rank >= wg_count) return;
    LAS float* red = (LAS float*)F.lds; LAS float* rs = (LAS float*)(F.lds + 32768);
    const int N = which == 1 ? NCOL : which == 3 ? NUP : DM;
    if (wg_rank >= N / 32) return;
    if (which == 1 || which == 3) sample_rstd(F, rs);
    for (int u = wg_rank; u < N / 32; u += wg_count) {
        if (which == 1) small_gemm_unit(F, red, (const bf16*)(F.ws + WS_XSB), (const bf16*)(F.ws + WS_WIN + layer * SZ_WIN), DM, 32 * u, EpiS_scale{(float*)(F.ws + WS_ZS), NCOL, rs});
        else if (which == 2) small_gemm_unit(F, red, (const bf16*)(F.ws + WS_MIXS), (const bf16*)(F.ws + WS_WOUT + layer * SZ_WOUT), DM, 32 * u, EpiS_res{(float*)(F.ws + WS_XS), (bf16*)(F.ws + WS_XSB)});
        else if (which == 3) small_gemm_unit(F, red, (const bf16*)(F.ws + WS_XSB), (const bf16*)(F.ws + WS_WUP + layer * SZ_WUP), DM, 32 * u, EpiS_scale{(float*)(F.ws + WS_US), NUP, rs});
        else small_gemm_unit(F, red, (const bf16*)(F.ws + WS_HFS), (const bf16*)(F.ws + WS_WDN + layer * SZ_WDN), DFF, 32 * u, EpiS_res{(float*)(F.ws + WS_XS), (bf16*)(F.ws + WS_XSB)});
    }
}

__device__ __forceinline__ unsigned opaque(unsigned x) { asm volatile("" : "+v"(x)); return x; }
struct ImgAddr { unsigned RB, TB0, TB1, TP; };
__device__ __forceinline__ ImgAddr make_img_addr(unsigned lane) { const unsigned g = lane >> 4; ImgAddr a; a.RB = off_b(lane & 15, g); a.TB0 = tr_addr(lane, 8 * g, 0); a.TB1 = tr_addr(lane, 8 * g + 4, 0); a.TP = tr_addr(lane, 4 * g, 0); return a; }
#define FRAG_ROW(img, A, rb, s) lds_frag(lds + (img) + 4096 * (rb), (A).RB ^ ((s) << 6))
#define FRAG_TRN(img, A, ks, c) cat8(tr_read(lds + (img) + 8192 * (ks), (A).TB0 ^ ((c) << 5)), tr_read(lds + (img) + 8192 * (ks), (A).TB1 ^ ((c) << 5)))
#define FRAG_TRP(img, A, k0, k1, c) cat8(tr_read(lds + (img) + 4096 * (k0), (A).TP ^ ((c) << 5)), tr_read(lds + (img) + 4096 * (k1), (A).TP ^ ((c) << 5)))
constexpr size_t WS_USTATE = WS_U, WS_SFRAG = WS_U + 64 * MiB, WS_DEC = WS_U + 96 * MiB;
static_assert(WS_DEC + 1024 * 512 <= WS_U + (size_t)MP * NUP * 2, "scan scratch overlays the (dead) up-projection buffer");
constexpr int CH_QH = 0, CH_KL = 16384, CH_V = 32768, CH_O = 49152, CH_G = 81920, CH_TOT = 98304, CH_STAT = 106496;
struct ChainRaw { u32x2 q[4], k[4], v[4], g[4]; f32x4 lf[4]; };
template <bool FULL> __device__ __forceinline__ void chain_load(ChainRaw& r, const bf16* Z, const float* LOGF, int unit, int tq, int dg) {
    const int chain = unit >> 5, c = unit & 31, grp = chain >> 4, b = (chain & 15) >> 2, h = chain & 3;
    const int cq = (grp ? C_QC : C_QA) + h * 128, ck = (grp ? C_KC : C_FA) + h * 128, cv = (grp ? C_VC : C_IA) + h * 128, cg = (grp ? C_GC : C_GA) + h * 128;
    const size_t R0 = (size_t)b * SEQ + 64 * c + 4 * tq;
#pragma unroll
    for (int i = 0; i < 4; ++i) { const bf16* zr = Z + (R0 + i) * NCOL + 4 * dg; r.k[i] = *(const u32x2*)(zr + ck); r.v[i] = *(const u32x2*)(zr + cv);
        if (FULL) { r.q[i] = *(const u32x2*)(zr + cq); r.g[i] = *(const u32x2*)(zr + cg); }
        if (grp == 0) r.lf[i] = *(const f32x4*)(LOGF + (R0 + i) * 512 + h * 128 + 4 * dg); else r.lf[i] = (f32x4){0.f, 0.f, 0.f, 0.f}; }
}
__device__ __forceinline__ void chain_prefix(LAS unsigned char* lds, const ChainRaw& raw, int grp, int h, int tq, unsigned bTOT, f32x4 (&bb)[4], f32x4& bl) {
    if (grp == 0) {
        f32x4 p[4]; p[0] = raw.lf[0]; p[1] = p[0] + raw.lf[1]; p[2] = p[1] + raw.lf[2]; p[3] = p[2] + raw.lf[3];
        *(LAS f32x4*)(lds + bTOT + tq * 512) = p[3];
        WG_BAR();
        f32x4 before = (f32x4){0.f, 0.f, 0.f, 0.f}, total = (f32x4){0.f, 0.f, 0.f, 0.f};
#pragma unroll 4
        for (int q = 0; q < 16; ++q) { const f32x4 t4 = *(const LAS f32x4*)(lds + bTOT + q * 512); total += t4; if (q < tq) before += t4; }
#pragma unroll
        for (int i = 0; i < 4; ++i) bb[i] = (before + p[i]) * LOG2E;
        bl = total * LOG2E;
    } else {
        WG_BAR();
        const float lg2 = log2f(1.0f - exp2f(-5.0f - (float)h));
#pragma unroll
        for (int i = 0; i < 4; ++i) { const float v = (float)(4 * tq + i + 1) * lg2; bb[i] = (f32x4){v, v, v, v}; }
        const float v = 64.0f * lg2; bl = (f32x4){v, v, v, v};
    }
}
__device__ __forceinline__ void chainA_units(Frame& F, int first, int count) {
    const int lane0 = F.lane, w = F.wave;
    LAS unsigned char* lds = F.lds;
    const bf16* Z = (const bf16*)(F.ws + WS_Z); const float* LOGF = (const float*)(F.ws + WS_LOGF);
    ChainRaw raw, rawn;
    { const int lane = (int)opaque((unsigned)lane0); chain_load<false>(raw, Z, LOGF, first, (w << 1) | (lane >> 5), lane & 31); }
    for (int ui = 0; ui < count; ++ui) {
        const int unit = first + ui, chain = unit >> 5, grp = chain >> 4, h = chain & 3;
        const int lane = (int)opaque((unsigned)lane0), tq = (w << 1) | (lane >> 5), dg = lane & 31;
        if (ui + 1 < count) chain_load<false>(rawn, Z, LOGF, unit + 1, tq, dg);
        const ImgAddr IA = make_img_addr(lane);
        const unsigned WA = 1024u * tq + 16u * ((dg >> 1) ^ (tq & 3)) + 8u * (dg & 1);
        const unsigned bTOT = opaque(CH_TOT + 16 * dg);
        f32x4 bl, bb[4];
        chain_prefix(lds, raw, grp, h, tq, bTOT, bb, bl);
        if (tq == 0) { f32x4 d; for (int j = 0; j < 4; ++j) d[j] = fexp2(fmaxf(bl[j], -125.0f)); *(f32x4*)((float*)(F.ws + WS_DEC) + (size_t)unit * 128 + 4 * dg) = d; }
        const float ksc = grp ? 0.08838834764831845f : 1.0f;
#pragma unroll
        for (int i = 0; i < 4; ++i) { const unsigned o8 = (WA ^ (i << 6)) + 256 * i; f32x4 ek;
#pragma unroll
            for (int j = 0; j < 4; ++j) ek[j] = fexp2(fmaxf(bl[j] - bb[i][j], -125.0f)) * ksc;
            u32x2 kl; kl.x = pk2(bflo(raw.k[i].x) * ek[0], bfhi(raw.k[i].x) * ek[1]); kl.y = pk2(bflo(raw.k[i].y) * ek[2], bfhi(raw.k[i].y) * ek[3]);
            *(LAS u32x2*)(lds + CH_KL + o8) = kl; *(LAS u32x2*)(lds + CH_V + o8) = raw.v[i]; }
        WG_BAR();
        f32x4 sacc[8];
#pragma unroll
        for (int n = 0; n < 8; ++n) sacc[n] = (f32x4){0.f, 0.f, 0.f, 0.f};
        { const unsigned wx = (unsigned)w << 5;
#pragma unroll
            for (int ks = 0; ks < 2; ++ks) { const bf16x8 af = cat8(tr_read(lds + CH_KL + 8192 * ks, IA.TB0 ^ wx), tr_read(lds + CH_KL + 8192 * ks, IA.TB1 ^ wx));
#pragma unroll
                for (int n = 0; n < 8; ++n) sacc[n] = MFMA16(af, FRAG_TRN(CH_V, IA, ks, n), sacc[n]); } }
        u32x2* up = (u32x2*)(F.ws + WS_USTATE) + ((size_t)(unit * 8 + w) * 8) * 64 + lane;
#pragma unroll
        for (int n = 0; n < 8; ++n) { u32x2 wv; wv.x = pk2(sacc[n][0], sacc[n][1]); wv.y = pk2(sacc[n][2], sacc[n][3]); up[n * 64] = wv; }
        WG_BAR();
        raw = rawn;
    }
}
__device__ __forceinline__ void chain_scan(Frame& F, int layer) {
    if (F.wave >= 4) return;
    const int tidx = F.vcu * 256 + F.tid; if (tidx >= 65536) return;
    const int chain = tidx >> 11, p = (tidx >> 9) & 3, n = (tidx >> 6) & 7, lane = tidx & 63, g = lane >> 4, l15 = lane & 15;
    const float* DEC = (const float*)(F.ws + WS_DEC); const u32x2* US = (const u32x2*)(F.ws + WS_USTATE); u32x4* SF = (u32x4*)(F.ws + WS_SFRAG);
    f32x4 S0 = (f32x4){0.f, 0.f, 0.f, 0.f}, S1 = S0;
    f32x4 Da[4], Db[4], nDa[4], nDb[4]; u32x2 Ua[4], Ub[4], nUa[4], nUb[4];
#define SCAN_LOAD(DA, DB, UA, UB, c0) do { _Pragma("unroll") for (int k = 0; k < 4; ++k) { const int unit = chain * 32 + (c0) + k; \
        DA[k] = *(const f32x4*)(DEC + (size_t)unit * 128 + 32 * p + 4 * g); DB[k] = *(const f32x4*)(DEC + (size_t)unit * 128 + 32 * p + 16 + 4 * g); \
        UA[k] = US[((size_t)(unit * 8 + 2 * p) * 8 + n) * 64 + lane]; UB[k] = US[((size_t)(unit * 8 + 2 * p + 1) * 8 + n) * 64 + lane]; } } while (0)
    SCAN_LOAD(Da, Db, Ua, Ub, 0);
#pragma unroll 1
    for (int cb = 0; cb < 32; cb += 4) {
        if (cb + 4 < 32) SCAN_LOAD(nDa, nDb, nUa, nUb, cb + 4);
#pragma unroll
        for (int k = 0; k < 4; ++k) { const int unit = chain * 32 + cb + k;
            const f32x4 d0 = Da[k] * S0, d1 = Db[k] * S1;
            u32x4 wv; wv.x = pk2(d0[0], d0[1]); wv.y = pk2(d0[2], d0[3]); wv.z = pk2(d1[0], d1[1]); wv.w = pk2(d1[2], d1[3]);
            SF[((size_t)(unit * 4 + p) * 8 + n) * 64 + lane] = wv;
            S0 = d0 + (f32x4){bflo(Ua[k].x), bfhi(Ua[k].x), bflo(Ua[k].y), bfhi(Ua[k].y)}; S1 = d1 + (f32x4){bflo(Ub[k].x), bfhi(Ub[k].x), bflo(Ub[k].y), bfhi(Ub[k].y)}; }
#pragma unroll
        for (int k = 0; k < 4; ++k) { Da[k] = nDa[k]; Db[k] = nDb[k]; Ua[k] = nUa[k]; Ub[k] = nUb[k]; }
    }
#undef SCAN_LOAD
    const int grp = chain >> 4, bh = chain & 15;
    float* So = F.out + (grp ? O_PRET : O_PHGRN) + ((size_t)layer * BATCH * 4 + bh) * 16384;
#pragma unroll
    for (int j = 0; j < 4; ++j) { So[(32 * p + 4 * g + j) * 128 + 16 * n + l15] = S0[j]; So[(32 * p + 16 + 4 * g + j) * 128 + 16 * n + l15] = S1[j]; }
}
__device__ __forceinline__ void chainC_units(Frame& F, int layer, int first, int count) {
    const int lane0 = F.lane, w = F.wave, tb = w & 3, nh = w >> 2;
    LAS unsigned char* lds = F.lds;
    const bf16* Z = (const bf16*)(F.ws + WS_Z); const float* LOGF = (const float*)(F.ws + WS_LOGF); bf16* MIX = (bf16*)(F.ws + WS_MIX);
    ChainRaw raw; bf16x8 sf[4][4], sfn[4][4]; f32x4 gn4;
    { const int lane = (int)opaque((unsigned)lane0); chain_load<true>(raw, Z, LOGF, first, (w << 1) | (lane >> 5), lane & 31);
      const bf16x8* sp = (const bf16x8*)(F.ws + WS_SFRAG) + ((size_t)first * 4 * 8 + 4 * nh) * 64 + lane;
#pragma unroll
      for (int p = 0; p < 4; ++p)
#pragma unroll
          for (int i = 0; i < 4; ++i) sf[p][i] = sp[(p * 8 + i) * 64];
      const int chain0 = first >> 5; gn4 = *(const f32x4*)(((chain0 >> 4) ? F.ret_g : F.hgrn_g) + layer * 512 + (chain0 & 3) * 128 + 4 * (lane & 31)); }
    for (int ui = 0; ui < count; ++ui) {
        const int unit = first + ui, chain = unit >> 5, c = unit & 31, grp = chain >> 4, b = (chain & 15) >> 2, h = chain & 3;
        const int lane = (int)opaque((unsigned)lane0), g = lane >> 4, l15 = lane & 15, tq = (w << 1) | (lane >> 5), dg = lane & 31;
        if (ui + 1 < count) { const bf16x8* sp = (const bf16x8*)(F.ws + WS_SFRAG) + ((size_t)(unit + 1) * 4 * 8 + 4 * nh) * 64 + lane;
#pragma unroll
            for (int p = 0; p < 4; ++p)
#pragma unroll
                for (int i = 0; i < 4; ++i) sfn[p][i] = sp[(p * 8 + i) * 64]; }
        const ImgAddr IA = make_img_addr(lane);
        const unsigned WA = 1024u * tq + 16u * ((dg >> 1) ^ (tq & 3)) + 8u * (dg & 1);
        const unsigned QP = 256u * l15 + 16u * ((g >> 1) ^ (((l15 & 3) << 2) | ((l15 >> 2) & 3))) + 8u * (g & 1);
        const unsigned bO = opaque(CH_O + ((16 * tb + 4 * g) * 128 + 64 * nh + l15) * 4), bOr = opaque(CH_O + (4 * tq * 128 + 4 * dg) * 4);
        const unsigned bTOT = opaque(CH_TOT + 16 * dg), bSTAT = opaque(CH_STAT), bG = opaque(CH_G + (4 * tq * 128 + 4 * dg) * 2);
        f32x4 bl, bb[4];
        chain_prefix(lds, raw, grp, h, tq, bTOT, bb, bl);
#ifdef CC_REP_P
        WG_BAR(); chain_prefix(lds, raw, grp, h, tq, bTOT, bb, bl);
#endif
#ifdef CC_REP_A
        for (int rep_ = 0; rep_ < 2; ++rep_) { asm volatile("" ::: "memory");
#endif
        const float ksc = grp ? 0.08838834764831845f : 1.0f;
        {
#pragma unroll
        for (int i = 0; i < 4; ++i) { const unsigned o8 = (WA ^ (i << 6)) + 256 * i;
            f32x4 eq, ek;
#pragma unroll
            for (int j = 0; j < 4; ++j) { eq[j] = fexp2(fminf(bb[i][j] - bl[j], 115.0f)); ek[j] = fexp2(fmaxf(bl[j] - bb[i][j], -125.0f)) * ksc; }
            u32x2 qh, kl, gg; qh.x = pk2(bflo(raw.q[i].x) * eq[0], bfhi(raw.q[i].x) * eq[1]); qh.y = pk2(bflo(raw.q[i].y) * eq[2], bfhi(raw.q[i].y) * eq[3]);
            kl.x = pk2(bflo(raw.k[i].x) * ek[0], bfhi(raw.k[i].x) * ek[1]); kl.y = pk2(bflo(raw.k[i].y) * ek[2], bfhi(raw.k[i].y) * ek[3]);
            gg.x = pk2(gn4[0] * silu(bflo(raw.g[i].x)), gn4[1] * silu(bfhi(raw.g[i].x))); gg.y = pk2(gn4[2] * silu(bflo(raw.g[i].y)), gn4[3] * silu(bfhi(raw.g[i].y)));
            *(LAS u32x2*)(lds + CH_QH + o8) = qh; *(LAS u32x2*)(lds + CH_KL + o8) = kl; *(LAS u32x2*)(lds + CH_V + o8) = raw.v[i]; *(LAS u32x2*)(lds + bG + i * 256) = gg; } }
#ifdef CC_REP_A
        }
#endif
        WG_BAR();
        if (ui + 1 < count) chain_load<true>(raw, Z, LOGF, unit + 1, tq, dg);
#ifdef CC_REP_M
        for (int rep_ = 0; rep_ < 2; ++rep_) { asm volatile("" ::: "memory");
#endif
        f32x4 att[4];
        { bf16x8 qf[4]; const unsigned qoff = 4096u * tb;
#pragma unroll
            for (int ks = 0; ks < 4; ++ks) qf[ks] = lds_frag(lds + CH_QH, qoff + (IA.RB ^ (ks << 6)));
#pragma unroll
            for (int sb = 0; sb < 4; ++sb) { att[sb] = (f32x4){0.f, 0.f, 0.f, 0.f};
#pragma unroll
                for (int ks = 0; ks < 4; ++ks) att[sb] = MFMA16(FRAG_ROW(CH_KL, IA, sb, ks), qf[ks], att[sb]);
#pragma unroll
                for (int j = 0; j < 4; ++j) att[sb][j] = (16 * sb + 4 * g + j <= 16 * tb + l15) ? att[sb][j] : 0.f; } }
        { const bf16x8 pf0 = pack8(att[0], att[1]), pf1 = pack8(att[2], att[3]);
            bf16x8 qp[4];
#pragma unroll
            for (int p = 0; p < 4; ++p) { const s16x4 lo = *(const LAS s16x4*)(lds + CH_QH + 4096 * tb + (QP ^ ((4 * p) << 4))), hi = *(const LAS s16x4*)(lds + CH_QH + 4096 * tb + (QP ^ ((4 * p + 2) << 4))); qp[p] = cat8(lo, hi); }
            f32x4 oc[4];
#pragma unroll
            for (int i = 0; i < 4; ++i) { const unsigned nx = (unsigned)(4 * nh + i) << 5; f32x4 a = (f32x4){0.f, 0.f, 0.f, 0.f};
                a = MFMA16(pf0, cat8(tr_read(lds + CH_V, IA.TP ^ nx), tr_read(lds + CH_V + 4096, IA.TP ^ nx)), a);
                a = MFMA16(pf1, cat8(tr_read(lds + CH_V + 8192, IA.TP ^ nx), tr_read(lds + CH_V + 12288, IA.TP ^ nx)), a);
#pragma unroll
                for (int p = 0; p < 4; ++p) a = MFMA16(qp[p], sf[p][i], a);
                oc[i] = a; }
#pragma unroll
            for (int j = 0; j < 4; ++j) { float s = (oc[0][j] + oc[1][j]) + (oc[2][j] + oc[3][j]), q = (oc[0][j] * oc[0][j] + oc[1][j] * oc[1][j]) + (oc[2][j] * oc[2][j] + oc[3][j] * oc[3][j]);
                s += __shfl_xor(s, 1); q += __shfl_xor(q, 1); s += __shfl_xor(s, 2); q += __shfl_xor(q, 2); s += __shfl_xor(s, 4); q += __shfl_xor(q, 4); s += __shfl_xor(s, 8); q += __shfl_xor(q, 8);
                const int t = 16 * tb + 4 * g + j;
                if (l15 == 0) *(LAS f32x2*)(lds + bSTAT + t * 16 + nh * 8) = (f32x2){s, q};
#pragma unroll
                for (int i = 0; i < 4; ++i) *(LAS float*)(lds + bO + j * 512 + i * 64) = oc[i][j]; } }
#ifdef CC_REP_M
        }
#endif
        WG_BAR();
#ifdef CC_REP_F
        for (int rep_ = 0; rep_ < 2; ++rep_)
#endif
        { const size_t Rp = (size_t)b * SEQ + 64 * c + 4 * tq; const int mixoff = (grp ? 1536 : 0) + h * 128;
#pragma unroll
            for (int i = 0; i < 4; ++i) { const int t = 4 * tq + i; const f32x4 o = *(const LAS f32x4*)(lds + bOr + i * 512); const f32x4 sp = *(const LAS f32x4*)(lds + bSTAT + t * 16); const u32x2 gv = *(const LAS u32x2*)(lds + bG + i * 256);
                const float mean = grp ? (sp[0] + sp[2]) * (1.0f / 128.0f) : 0.f; const float var = (sp[1] + sp[3]) * (1.0f / 128.0f) - mean * mean; const float rs = __builtin_amdgcn_rsqf(fmaxf(var, 0.f) + EPS);
                u32x2 wv; wv.x = pk2((o[0] - mean) * rs * bflo(gv.x), (o[1] - mean) * rs * bfhi(gv.x)); wv.y = pk2((o[2] - mean) * rs * bflo(gv.y), (o[3] - mean) * rs * bfhi(gv.y));
                *(u32x2*)(MIX + (Rp + i) * DM + mixoff + 4 * dg) = wv; } }
#pragma unroll
        for (int p = 0; p < 4; ++p)
#pragma unroll
            for (int i = 0; i < 4; ++i) sf[p][i] = sfn[p][i];
    }
    WG_BAR();
}

constexpr int SW_K = 0, SW_V = 65536;
__device__ __forceinline__ void swa_prompt_unit(Frame& F, int layer, int unit) {
    const int tid = F.tid, lane = F.lane, w = F.wave, g = lane >> 4, l15 = lane & 15;
    LAS unsigned char* lds = F.lds;
    const bf16* Z = (const bf16*)(F.ws + WS_Z); bf16* MIX = (bf16*)(F.ws + WS_MIX);
    const int hp = unit & 1, kvh = (unit >> 1) & 1, n = (unit >> 2) & 15, b = unit >> 6;
#pragma unroll
    for (int it_ = 0; it_ < 8; ++it_) { const int idx = tid + it_ * NTHR; const int row = idx >> 4, ch = idx & 15; u32x4 kx = (u32x4){0u, 0u, 0u, 0u}, vx = kx;
        if (n > 0 || row >= 128) { const bf16* zr = Z + ((size_t)b * SEQ + 128 * (n - 1) + row) * NCOL; kx = *(const u32x4*)(zr + C_KB + kvh * 128 + ch * 8); vx = *(const u32x4*)(zr + C_VB + kvh * 128 + ch * 8); }
        *(LAS u32x4*)(lds + SW_K + off_b(row, ch)) = kx; *(LAS u32x4*)(lds + SW_V + off_b(row, ch)) = vx; }
    bf16x8 qall[2][4];
    { const int r_ = 16 * w + l15;
#pragma unroll
      for (int hq = 0; hq < 2; ++hq) { const bf16* qr = Z + ((size_t)b * SEQ + 128 * n + r_) * NCOL + C_QB + (kvh * 4 + 2 * hp + hq) * 128 + 8 * g;
#pragma unroll
          for (int ks = 0; ks < 4; ++ks) qall[hq][ks] = *(const bf16x8*)(qr + 32 * ks); } }
    LDS_WAIT(); __syncthreads();
    const ImgAddr IA = make_img_addr(lane);
    const unsigned wo = 4096u * w;
    const unsigned bV = opaque(SW_V + wo + IA.TP);
    const int r = 16 * w + l15;
    for (int hh = 2 * hp; hh < 2 * hp + 2; ++hh) {
        const int h = kvh * 4 + hh;
        const float slope2 = exp2f(-(float)(h + 1)) * LOG2E, sink2 = F.sinks[layer * 8 + h] * LOG2E, c1 = 0.08838834764831845f * LOG2E;
        bf16x8 qf[4];
#pragma unroll
        for (int ks = 0; ks < 4; ++ks) qf[ks] = (hh & 1) ? qall[1][ks] : qall[0][ks];
        f32x4 st[10]; float m = -INFINITY;
#pragma unroll
        for (int i = 0; i < 9; ++i) { f32x4 a = (f32x4){0.f, 0.f, 0.f, 0.f};
#pragma unroll
            for (int ks = 0; ks < 4; ++ks) a = MFMA16(lds_frag(lds + SW_K + 4096 * i, wo + (IA.RB ^ (ks << 6))), qf[ks], a);
#pragma unroll
            for (int j = 0; j < 4; ++j) { const int key = 16 * (w + i) + 4 * g + j, dist = 128 + r - key; const bool ok = dist >= 0 && dist < 128 && (n > 0 || key >= 128);
                a[j] = ok ? a[j] * c1 - slope2 * (float)dist : -INFINITY; m = fmaxf(m, a[j]); }
            st[i] = a; }
        m = fmaxf(m, __shfl_xor(m, 16)); m = fmaxf(m, __shfl_xor(m, 32)); m = fmaxf(m, sink2);
        float sum = 0.f;
#pragma unroll
        for (int i = 0; i < 9; ++i)
#pragma unroll
            for (int j = 0; j < 4; ++j) { const float p = fexp2(fmaxf(st[i][j] - m, -125.0f)); st[i][j] = p; sum += p; }
        st[9] = (f32x4){0.f, 0.f, 0.f, 0.f};
        sum += __shfl_xor(sum, 16); sum += __shfl_xor(sum, 32);
        const float inv = frcp(sum + fexp2(fmaxf(sink2 - m, -125.0f)));
        f32x4 oc[8];
#pragma unroll
        for (int c = 0; c < 8; ++c) oc[c] = (f32x4){0.f, 0.f, 0.f, 0.f};
#pragma unroll
        for (int pp = 0; pp < 5; ++pp) { const bf16x8 pf = pack8(st[2 * pp], st[2 * pp + 1]);
#pragma unroll
            for (int c = 0; c < 8; ++c) oc[c] = MFMA16(pf, cat8(tr_read(lds + 4096 * (2 * pp), bV ^ (c << 5)), tr_read(lds + 4096 * (pp < 4 ? 2 * pp + 1 : 2 * pp), bV ^ (c << 5))), oc[c]); }
#pragma unroll
        for (int j = 0; j < 4; ++j) { const float iv = __shfl(inv, 4 * g + j); bf16* mr = MIX + ((size_t)b * SEQ + 128 * n + 16 * w + 4 * g + j) * DM + 512 + h * 128 + l15;
#pragma unroll
            for (int c = 0; c < 8; ++c) mr[16 * c] = (bf16)(pk2(oc[c][j] * iv, 0.f) & 0xffffu); }
    }
    LDS_WAIT(); __syncthreads();
}

__device__ __forceinline__ void sample_linrec_unit(Frame& F, int layer, int unit) {
    const int grp = unit >> 7, bh = unit & 127, b = bh >> 2, h = bh & 3, tid = F.tid;
    const float* zs = (const float*)(F.ws + WS_ZS) + (size_t)b * NCOL;
    const float* Sin = (grp ? F.state_ret : F.state_hgrn) + ((size_t)layer * DB * 4 + bh) * 16384;
    float* So = F.out + (grp ? O_SRET : O_SHGRN) + ((size_t)layer * DB * 4 + bh) * 16384;
    LAS float* red = (LAS float*)F.lds;
    LAS float* ov = (LAS float*)(F.lds + 8192);
    const int dvq = tid & 31, r0 = tid >> 5;
    const int cq = (grp ? C_QC : C_QA) + h * 128, cv = (grp ? C_VC : C_IA) + h * 128, cg = (grp ? C_GC : C_GA) + h * 128;
    const f32x4 v4 = *(const f32x4*)(zs + cv + 4 * dvq);
    const float gamma = 1.0f - exp2f(-5.0f - (float)h);
    f32x4 po = (f32x4){0.f, 0.f, 0.f, 0.f};
    f32x4 s4[8]; float qv[8], xv[8], la[8], lb2[8];
#pragma unroll
    for (int i = 0; i < 8; ++i) { const int dk = r0 + 16 * i; qv[i] = zs[cq + dk]; xv[i] = zs[(grp ? C_KC : C_FA) + h * 128 + dk]; la[i] = 0.f; lb2[i] = 0.f;
        if (grp == 0 && layer == 1) { la[i] = F.lbraw[h * 128 + dk]; lb2[i] = F.lbraw[512 + h * 128 + dk]; }
        s4[i] = *(const f32x4*)(Sin + (size_t)dk * 128 + 4 * dvq); }
#pragma unroll
    for (int i = 0; i < 8; ++i) { const int dk = r0 + 16 * i; const float q = qv[i]; float f, kk;
        if (grp == 0) { const float fa = xv[i]; float lb = 0.f; if (layer == 1) lb = 1.0f / (1.0f + __expf(la[i] - lb2[i]));
            const float e = __expf(-fabsf(fa)), inv = 1.0f / (1.0f + e), s = fa >= 0.f ? inv : e * inv, sm = fa >= 0.f ? e * inv : inv; f = lb + (1.0f - lb) * s; kk = (1.0f - lb) * sm; }
        else { f = gamma; kk = xv[i] * 0.08838834764831845f; }
        const f32x4 sn = s4[i] * f + v4 * kk;
        *(f32x4*)(So + (size_t)dk * 128 + 4 * dvq) = sn; po += sn * q; }
    *(LAS f32x4*)(red + r0 * 128 + 4 * dvq) = po;
    LDS_WAIT(); __syncthreads();
    if (tid < 128) { float s = 0.f;
#pragma unroll
        for (int i = 0; i < 16; ++i) s += red[i * 128 + tid];
        ov[tid] = s; }
    LDS_WAIT(); __syncthreads();
    if (F.wave == 0) { const int lane = F.lane; const float a0 = ov[lane], a1 = ov[64 + lane];
        const float mean = grp ? wave_sum(a0 + a1) * (1.0f / 128.0f) : 0.f; const float c0 = a0 - mean, c1 = a1 - mean;
        const float rr = 1.0f / sqrtf(wave_sum(c0 * c0 + c1 * c1) * (1.0f / 128.0f) + EPS);
        const float* gn = (grp ? F.ret_g : F.hgrn_g) + layer * 512 + h * 128; bf16* mo = (bf16*)(F.ws + WS_MIXS) + (size_t)b * DM + (grp ? 1536 : 0) + h * 128;
        mo[lane] = (bf16)(pk2(c0 * rr * gn[lane] * silu(zs[cg + lane]), 0.f) & 0xffffu); mo[64 + lane] = (bf16)(pk2(c1 * rr * gn[64 + lane] * silu(zs[cg + 64 + lane]), 0.f) & 0xffffu); }
    LDS_WAIT(); __syncthreads();
}
constexpr int SS_K = 0, SS_V = 67584, SS_ROW = 132;
__device__ __forceinline__ void sample_swa_unit(Frame& F, int layer, int unit) {
    const int tid = F.tid, lane = F.lane, b = unit >> 1, kvh = unit & 1;
    LAS float* Ks = (LAS float*)(F.lds + SS_K); LAS float* Vs = (LAS float*)(F.lds + SS_V);
    const float* zs = (const float*)(F.ws + WS_ZS) + (size_t)b * NCOL;
    const float* ck = F.cache_k + ((size_t)layer * DB + b) * 128 * 256 + kvh * 128; const float* cvv = F.cache_v + ((size_t)layer * DB + b) * 128 * 256 + kvh * 128;
#pragma unroll
    for (int i = 0; i < 8; ++i) { const int idx = tid + i * NTHR, j = idx >> 5, c4 = (idx & 31) * 4;
        const float* kr = j < 127 ? ck + (size_t)(j + 1) * 256 + c4 : zs + C_KB + kvh * 128 + c4; const float* vr = j < 127 ? cvv + (size_t)(j + 1) * 256 + c4 : zs + C_VB + kvh * 128 + c4;
        const f32x4 k4 = *(const f32x4*)kr, v4 = *(const f32x4*)vr;
        *(LAS f32x4*)(Ks + j * SS_ROW + c4) = k4; *(LAS f32x4*)(Vs + j * SS_ROW + c4) = v4; }
    LDS_WAIT(); __syncthreads();
    if (F.wave < 4) {
        const int h = kvh * 4 + F.wave; const float slope = exp2f(-(float)(h + 1)), sink = F.sinks[layer * 8 + h];
        float sc[2] = {0.f, 0.f};
#pragma unroll 8
        for (int d = 0; d < 128; d += 4) { const f32x4 q4 = *(const f32x4*)(zs + C_QB + h * 128 + d); const f32x4 ka = *(const LAS f32x4*)(Ks + lane * SS_ROW + d), kb = *(const LAS f32x4*)(Ks + (lane + 64) * SS_ROW + d);
            sc[0] += (ka[0] * q4[0] + ka[1] * q4[1]) + (ka[2] * q4[2] + ka[3] * q4[3]); sc[1] += (kb[0] * q4[0] + kb[1] * q4[1]) + (kb[2] * q4[2] + kb[3] * q4[3]); }
        sc[0] = sc[0] * 0.08838834764831845f - slope * (float)(127 - lane); sc[1] = sc[1] * 0.08838834764831845f - slope * (float)(63 - lane);
        const float m = fmaxf(wave_max(fmaxf(sc[0], sc[1])), sink);
        const float p0 = __expf(sc[0] - m), p1 = __expf(sc[1] - m);
        const float den = wave_sum(p0 + p1) + __expf(sink - m);
        float o0 = 0.f, o1 = 0.f;
#pragma unroll 16
        for (int j = 0; j < 128; ++j) { const float pj = __shfl(j < 64 ? p0 : p1, j & 63); const f32x2 v2 = *(const LAS f32x2*)(Vs + j * SS_ROW + 2 * lane); o0 += pj * v2.x; o1 += pj * v2.y; }
        *(unsigned*)((bf16*)(F.ws + WS_MIXS) + (size_t)b * DM + 512 + h * 128 + 2 * lane) = pk2(o0 / den, o1 / den);
    }
    LDS_WAIT(); __syncthreads();
}
__device__ __forceinline__ void kv_window_outputs(Frame& F, int layer, int rank, int count) {
    const bf16* Z = (const bf16*)(F.ws + WS_Z); const float* ZS = (const float*)(F.ws + WS_ZS);
    const size_t nthr = (size_t)count * NTHR, t0 = (size_t)rank * NTHR + F.tid;
    for (size_t q = t0; q < (size_t)BATCH * 128 * 64; q += nthr) { const size_t i = q * 4; const int c = (int)(i & 255), j = (int)((i >> 8) & 127), b = (int)(i >> 15); const size_t row = (size_t)b * SEQ + SEQ - 128 + j;
        const u32x2 kk = *(const u32x2*)(Z + row * NCOL + C_KB + c), vv = *(const u32x2*)(Z + row * NCOL + C_VB + c);
        *(f32x4*)(F.out + O_PK + (size_t)layer * BATCH * 32768 + i) = (f32x4){bflo(kk.x), bfhi(kk.x), bflo(kk.y), bfhi(kk.y)}; *(f32x4*)(F.out + O_PV + (size_t)layer * BATCH * 32768 + i) = (f32x4){bflo(vv.x), bfhi(vv.x), bflo(vv.y), bfhi(vv.y)}; }
    const float* ck = F.cache_k + (size_t)layer * DB * 32768; const float* cvv = F.cache_v + (size_t)layer * DB * 32768;
    for (size_t q = t0; q < (size_t)DB * 128 * 64; q += 2 * nthr) { f32x4 kk[2], vv[2];
#pragma unroll
        for (int e = 0; e < 2; ++e) { const size_t qq = q + e * nthr; if (qq < (size_t)DB * 128 * 64) { const size_t i = qq * 4; const int c = (int)(i & 255), j = (int)((i >> 8) & 127), b = (int)(i >> 15);
            kk[e] = j < 127 ? *(const f32x4*)(ck + i + 256) : *(const f32x4*)(ZS + (size_t)b * NCOL + C_KB + c); vv[e] = j < 127 ? *(const f32x4*)(cvv + i + 256) : *(const f32x4*)(ZS + (size_t)b * NCOL + C_VB + c); } }
#pragma unroll
        for (int e = 0; e < 2; ++e) { const size_t qq = q + e * nthr; if (qq < (size_t)DB * 128 * 64) { const size_t i = qq * 4;
            *(f32x4*)(F.out + O_SK + (size_t)layer * DB * 32768 + i) = kk[e]; *(f32x4*)(F.out + O_SV + (size_t)layer * DB * 32768 + i) = vv[e]; } } }
}
__device__ __forceinline__ void sample_mixers(Frame& F, int layer, int rank, int count) {
    for (int u = rank; u < 256; u += count) { F.tid = (int)opq_u32(threadIdx.x); F.lane = F.tid & 63; sample_linrec_unit(F, layer, u); }
    for (int u = rank - 64; u >= 0 && u < 64; u += count) { F.tid = (int)opq_u32(threadIdx.x); F.lane = F.tid & 63; sample_swa_unit(F, layer, u); }
}
__device__ __forceinline__ void p2a_mixers(Frame& F, int layer) {
    const int wg = F.bid, cnt = F.G;
#ifdef REP_CA2
    for (int rep_ = 0; rep_ < 2; ++rep_)
#endif
    for (int u0 = 4 * wg; u0 < 1024; u0 += 4 * cnt) { F.tid = (int)opq_u32(threadIdx.x); F.lane = F.tid & 63; chainA_units(F, u0, 4); }
    sample_mixers(F, layer, wg, cnt);
    F.tid = (int)opq_u32(threadIdx.x); F.lane = F.tid & 63;
    kv_window_outputs(F, layer, wg, cnt);
}
__device__ __forceinline__ void p2b_mixers(Frame& F, int layer) {
    chain_scan(F, layer);
    __syncthreads();
    for (int u = F.bid; u < 256; u += F.G) { F.tid = (int)opq_u32(threadIdx.x); F.lane = F.tid & 63; swa_prompt_unit(F, layer, u); }
}
__device__ __forceinline__ void p2c_mixers(Frame& F, int layer) {
#ifdef REP_CC2
    for (int rep_ = 0; rep_ < 2; ++rep_)
#endif
    for (int u0 = 4 * F.bid; u0 < 1024; u0 += 4 * F.G) { F.tid = (int)opq_u32(threadIdx.x); F.lane = F.tid & 63; chainC_units(F, layer, u0, 4); }
}
constexpr size_t WS_UH = WS_U + 100 * MiB;
__device__ __forceinline__ void p5_conv(Frame& F, int layer) {
    const float* UH = (const float*)(F.ws + WS_UH); bf16* HF = (bf16*)(F.ws + WS_HF);
    const float* cw = F.conv_w + (size_t)layer * 3 * NUP; const float* cb = F.conv_b + (size_t)layer * NUP;
    const size_t nthr = (size_t)F.G * NTHR, t0 = (size_t)F.vcu * NTHR + F.tid;
    constexpr size_t N_FIX = (size_t)32 * 44 * 2 * 128;
    for (size_t base = t0; base < N_FIX; base += 3 * nthr) { float u0[3][2], u1[3][2], u2[3][2], w0[3][2], w1[3][2], w2[3][2], bb[3][2]; bool on[3];
#pragma unroll
        for (int e = 0; e < 3; ++e) { const size_t it = base + e * nthr; on[e] = false; if (it < N_FIX) {
            const int i = (int)(it & 127), t = (int)((it >> 7) & 1), pn = (int)((it >> 8) % 44), pm = (int)((it >> 8) / 44);
            if ((pm & 7) != 0) { on[e] = true; const float* cur = UH + (size_t)(pm * 44 + pn) * 1024; const float* prv = UH + (size_t)((pm - 1) * 44 + pn) * 1024;
#pragma unroll
                for (int hf = 0; hf < 2; ++hf) { const int ct = hf * 128 + i, col = hf * DFF + 128 * pn + i;
                    u0[e][hf] = cur[t * 256 + ct]; u1[e][hf] = t == 0 ? prv[3 * 256 + ct] : cur[ct]; u2[e][hf] = t == 0 ? prv[2 * 256 + ct] : prv[3 * 256 + ct];
                    bb[e][hf] = cb[col]; w0[e][hf] = cw[col]; w1[e][hf] = cw[NUP + col]; w2[e][hf] = cw[2 * NUP + col]; } } } }
#pragma unroll
        for (int e = 0; e < 3; ++e) if (on[e]) { const size_t it = base + e * nthr; const int i = (int)(it & 127), t = (int)((it >> 7) & 1), pn = (int)((it >> 8) % 44), pm = (int)((it >> 8) / 44);
            const float c0 = bb[e][0] + w0[e][0] * u2[e][0] + w1[e][0] * u1[e][0] + w2[e][0] * u0[e][0], c1 = bb[e][1] + w0[e][1] * u2[e][1] + w1[e][1] * u1[e][1] + w2[e][1] * u0[e][1];
            HF[(size_t)(256 * pm + t) * DFF + 128 * pn + i] = (bf16)(pk2(gelu_tanh(c0) * c1, 0.f) & 0xffffu); }
    }
    for (size_t it = t0; it < (size_t)BATCH * 2 * NUP; it += nthr) {
        const int col = (int)(it % NUP), r = (int)((it / NUP) & 1), b = (int)(it / (2 * NUP)); const int hf = col >= DFF ? 1 : 0, cg = col - hf * DFF, pn = cg >> 7, i = cg & 127;
        F.out[O_PCONV + (((size_t)layer * BATCH + b) * 2 + r) * NUP + col] = UH[(size_t)((8 * b + 7) * 44 + pn) * 1024 + (2 + r) * 256 + hf * 128 + i];
    }
    const float* US = (const float*)(F.ws + WS_US); const float* pre = F.state_conv + (size_t)layer * DB * 2 * NUP; bf16* HFS = (bf16*)(F.ws + WS_HFS);
    for (size_t base = t0; base < (size_t)DB * DFF; base += 2 * nthr) { float u0[2][2], q0[2][2], q1[2][2], w0[2][2], w1[2][2], w2[2][2], bb[2][2];
#pragma unroll
        for (int e = 0; e < 2; ++e) { const size_t i = base + e * nthr; if (i < (size_t)DB * DFF) { const int j = (int)(i % DFF), b = (int)(i / DFF);
#pragma unroll
            for (int hf = 0; hf < 2; ++hf) { const int col = hf * DFF + j, ucol = 256 * (j >> 7) + 128 * hf + (j & 127); u0[e][hf] = US[(size_t)b * NUP + ucol];
                q0[e][hf] = pre[((size_t)b * 2 + 0) * NUP + col]; q1[e][hf] = pre[((size_t)b * 2 + 1) * NUP + col];
                bb[e][hf] = cb[col]; w0[e][hf] = cw[col]; w1[e][hf] = cw[NUP + col]; w2[e][hf] = cw[2 * NUP + col]; } } }
#pragma unroll
        for (int e = 0; e < 2; ++e) { const size_t i = base + e * nthr; if (i < (size_t)DB * DFF) { const int j = (int)(i % DFF), b = (int)(i / DFF); float c[2];
#pragma unroll
            for (int hf = 0; hf < 2; ++hf) { const int col = hf * DFF + j; c[hf] = bb[e][hf] + w0[e][hf] * q0[e][hf] + w1[e][hf] * q1[e][hf] + w2[e][hf] * u0[e][hf];
                float* so = F.out + O_SCONV + ((size_t)layer * DB + b) * 2 * NUP; so[col] = q1[e][hf]; so[NUP + col] = u0[e][hf]; }
            HFS[i] = (bf16)(pk2(gelu_tanh(c[0]) * c[1], 0.f) & 0xffffu); } }
    }
}
__device__ __forceinline__ void p_final(Frame& F) {
    const int gw = F.vcu * NWAVES + F.wave, NGW = F.G * NWAVES, lane = F.lane; const float* SS = (const float*)(F.ws + WS_SS); const bf16* XBp = (const bf16*)(F.ws + WS_XB);
    { f32x4 g0[4], g1[4];
#pragma unroll
      for (int j = 0; j < 4; ++j) { g0[j] = ((const f32x4*)F.fin_g)[(lane + 64 * j) * 2]; g1[j] = ((const f32x4*)F.fin_g)[(lane + 64 * j) * 2 + 1]; }
      u32x4 h[4], hn[4]; f32x4 sa, sb, san, sbn; int m = gw;
      if (m < MP) { const u32x4* hb = (const u32x4*)(XBp + (size_t)m * DM) + lane;
#pragma unroll
          for (int j = 0; j < 4; ++j) h[j] = hb[64 * j];
          sa = *(const f32x4*)(SS + (size_t)m * 8); sb = *(const f32x4*)(SS + (size_t)m * 8 + 4); }
      while (m < MP) { const int mn = m + NGW; const bool more = mn < MP;
          if (more) { const u32x4* hb = (const u32x4*)(XBp + (size_t)mn * DM) + lane;
#pragma unroll
              for (int j = 0; j < 4; ++j) hn[j] = hb[64 * j];
              san = *(const f32x4*)(SS + (size_t)mn * 8); sbn = *(const f32x4*)(SS + (size_t)mn * 8 + 4); }
          const float ssum = ((sa[0] + sa[1]) + (sa[2] + sa[3])) + ((sb[0] + sb[1]) + (sb[2] + sb[3])); const float r = 1.0f / sqrtf(ssum * (1.0f / 2048.0f) + 1e-6f);
          float* orow = F.out + O_YP + (size_t)m * DM;
#pragma unroll
          for (int j = 0; j < 4; ++j) { f32x4 v0, v1; v0[0] = bflo(h[j].x); v0[1] = bfhi(h[j].x); v0[2] = bflo(h[j].y); v0[3] = bfhi(h[j].y); v1[0] = bflo(h[j].z); v1[1] = bfhi(h[j].z); v1[2] = bflo(h[j].w); v1[3] = bfhi(h[j].w);
              ((f32x4*)orow)[(lane + 64 * j) * 2] = v0 * r * g0[j]; ((f32x4*)orow)[(lane + 64 * j) * 2 + 1] = v1 * r * g1[j]; }
          if (more) {
#pragma unroll
              for (int j = 0; j < 4; ++j) h[j] = hn[j];
              sa = san; sb = sbn; }
          m = mn; } }
    if (gw < DB) { const int q = gw; const f32x4* x4 = (const f32x4*)((const float*)(F.ws + WS_XS) + (size_t)q * DM) + lane; float* orow = F.out + O_YS + (size_t)q * DM; f32x4 v[8], gg[8]; float s = 0.f;
#pragma unroll
        for (int j = 0; j < 8; ++j) { v[j] = x4[64 * j]; gg[j] = ((const f32x4*)F.fin_g + lane)[64 * j]; }
#pragma unroll
        for (int j = 0; j < 8; ++j) s += (v[j][0] * v[j][0] + v[j][1] * v[j][1]) + (v[j][2] * v[j][2] + v[j][3] * v[j][3]);
        const float r = 1.0f / sqrtf(wave_sum(s) * (1.0f / DM) + EPS);
#pragma unroll
        for (int j = 0; j < 8; ++j) ((f32x4*)orow + lane)[64 * j] = v[j] * r * gg[j]; }
}
}
constexpr int N_PHASES = 18;
__global__ void __launch_bounds__(mk::NTHR, 2) mk_fwd(mk::Args args) {
    using namespace mk;
    extern __shared__ __attribute__((aligned(16))) unsigned char lds_raw[];
    Frame F;
    F.lds = (LAS unsigned char*)lds_raw;
    F.tid = threadIdx.x; F.lane = F.tid & 63; F.wave = __builtin_amdgcn_readfirstlane(F.tid >> 6);
    F.G = gridDim.x; F.bid = blockIdx.x; F.vcu = F.bid;
    F.ws = args.ws; F.out = args.out;
    F.x_prompt = args.in[0]; F.x_sample = args.in[1]; F.state_hgrn = args.in[2]; F.cache_k = args.in[3]; F.cache_v = args.in[4]; F.state_ret = args.in[5]; F.state_conv = args.in[6];
    F.norm1 = args.in[7]; F.w_in = args.in[8]; F.lbraw = args.in[9]; F.hgrn_g = args.in[10]; F.sinks = args.in[11]; F.ret_g = args.in[12]; F.w_out = args.in[13]; F.norm2 = args.in[14];
    F.w_up = args.in[15]; F.conv_w = args.in[16]; F.conv_b = args.in[17]; F.w_down = args.in[18]; F.fin_g = args.in[19];
    volatile LAS unsigned* MISC = (volatile LAS unsigned*)(F.lds + MISC_OFF);
    for (int u = F.tid; u < 256; u += NTHR) MISC[u] = 0u;
    __syncthreads();
    const int lo = args.ph_lo, hi = args.ph_hi;
    XcdBarrier bar; bar.bar = (unsigned*)(F.ws + WS_CTL) + CW_BAR; bar.x = 0; bar.st = nullptr;
    if (hi - lo > 1) bar = xcd_barrier_post((unsigned*)(F.ws + WS_CTL) + CW_BAR, MISC + 8);
#define REFRESH() do { F.tid = (int)opq_u32(threadIdx.x); F.lane = F.tid & 63; F.wave = __builtin_amdgcn_readfirstlane(F.tid >> 6); F.bid = __builtin_amdgcn_readfirstlane((int)opq_u32(blockIdx.x)); F.vcu = (F.G % 8 == 0) ? (F.bid % 8) * (F.G / 8) + F.bid / 8 : F.bid; } while (0)
#define IN(k) (lo <= (k) && (k) < hi)
#define NREP(k) (((args.rep_mask >> (k)) & 1u) ? 2 : 1)
#define REPSYNC() do { if (rep) xcd_barrier(bar); } while (0)
#define SEAM(k) do { if (IN(k) && IN((k) + 1)) xcd_barrier(bar); } while (0)
    bf16* XB = (bf16*)(F.ws + WS_XB); float* SS = (float*)(F.ws + WS_SS);
    if (IN(0)) for (int rep = 0; rep < NREP(0); ++rep) { REPSYNC(); REFRESH();
#ifndef SKIP_P0
 p0_prologue(F);
#endif
 } SEAM(0);
#pragma unroll 1
    for (int l = 0; l < DEPTH; ++l) {
        const int base = 1 + 8 * l;
        if (IN(base)) for (int rep = 0; rep < NREP(base); ++rep) { REPSYNC(); REFRESH();
            pg8::Gemm g{XB, (const bf16*)(F.ws + WS_WIN + l * SZ_WIN), MP, NCOL, DM}; pg8::InProjOrder S; S.init(MP, NCOL, F.G, F.bid);
            pg8::EpiZ E{(bf16*)(F.ws + WS_Z), (float*)(F.ws + WS_LOGF), SS, F.lbraw, l, NCOL, (LAS float*)(F.lds + 131072 + 16384)};

#ifndef SKIP_G1
 pg8::gemm_phase<pg8::EpiZ, pg8::InProjOrder, true, true>(F.lds, g, S, E);
#endif


#ifndef SKIP_SG
 REFRESH(); sample_gemm_phase(F, 1, l, F.bid - 192, 64);
#endif

        } SEAM(base);
        if (IN(base + 1)) for (int rep = 0; rep < NREP(base + 1); ++rep) { REPSYNC(); REFRESH();
 p2a_mixers(F, l);
 } SEAM(base + 1);
        if (IN(base + 2)) for (int rep = 0; rep < NREP(base + 2); ++rep) { REPSYNC(); REFRESH();
 p2b_mixers(F, l);
 } SEAM(base + 2);
        if (IN(base + 3)) for (int rep = 0; rep < NREP(base + 3); ++rep) { REPSYNC(); REFRESH();
 p2c_mixers(F, l);
 } SEAM(base + 3);
        if (IN(base + 4)) for (int rep = 0; rep < NREP(base + 4); ++rep) { REPSYNC(); REFRESH();
            if (!rep) { sample_kpart(F, 2, l, (unsigned*)(F.ws + WS_CTL) + CW_SUB + 64 * (2 * l)); REFRESH(); }
            pg8::Gemm g{(const bf16*)(F.ws + WS_MIX), (const bf16*)(F.ws + WS_WOUT + l * SZ_WOUT), MP, DM, DM}; pg8::StaticOrder S; S.init(MP, DM, F.G, F.bid);
            pg8::EpiRes E{l == 0 ? F.x_prompt : nullptr, XB, rep ? (bf16*)(F.ws + WS_U + 128 * MiB) : XB, rep ? (float*)(F.ws + WS_U + 128 * MiB + (size_t)MP * DM * 4) : SS};

#ifndef SKIP_GR
 pg8::gemm_phase<pg8::EpiRes, pg8::StaticOrder, false, true>(F.lds, g, S, E);
#endif


#ifndef SKIP_SG
 REFRESH(); if (!rep) { if (F.G == 256) sample_kreduce(F, (unsigned*)(F.ws + WS_CTL) + CW_SUB + 64 * (2 * l), bar.bar); else sample_gemm_phase(F, 2, l, F.bid, 64); }
#endif

        } SEAM(base + 4);
        if (IN(base + 5)) for (int rep = 0; rep < NREP(base + 5); ++rep) { REPSYNC(); REFRESH();
            pg8::Gemm g{XB, (const bf16*)(F.ws + WS_WUP + l * SZ_WUP), MP, NUP, DM}; pg8::StaticOrder S; S.init(MP, NUP, F.G, F.bid);
            pg8::EpiUF E{(bf16*)(F.ws + WS_HF), (float*)(F.ws + WS_UH), SS, F.conv_w + (size_t)l * 3 * NUP, F.conv_b + (size_t)l * NUP, (LAS float*)(F.lds + 131072)};

#ifndef SKIP_G3
 pg8::gemm_phase<pg8::EpiUF, pg8::StaticOrder, true, true>(F.lds, g, S, E);
#endif


#ifndef SKIP_SG
 REFRESH(); sample_gemm_phase(F, 3, l, F.bid - 128, 128);
#endif

        } SEAM(base + 5);
        if (IN(base + 6)) for (int rep = 0; rep < NREP(base + 6); ++rep) { REPSYNC(); REFRESH();
#ifndef SKIP_P5
 p5_conv(F, l);
#endif
 } SEAM(base + 6);
        if (IN(base + 7)) for (int rep = 0; rep < NREP(base + 7); ++rep) { REPSYNC(); REFRESH();
            if (!rep) { sample_kpart(F, 4, l, (unsigned*)(F.ws + WS_CTL) + CW_SUB + 64 * (2 * l + 1)); REFRESH(); }
            pg8::Gemm g{(const bf16*)(F.ws + WS_HF), (const bf16*)(F.ws + WS_WDN + l * SZ_WDN), MP, DM, DFF}; pg8::StaticOrder S; S.init(MP, DM, F.G, F.bid);
            pg8::EpiRes E{nullptr, XB, rep ? (bf16*)(F.ws + WS_U + 128 * MiB) : XB, rep ? (float*)(F.ws + WS_U + 128 * MiB + (size_t)MP * DM * 4) : SS};

#ifndef SKIP_GR
 pg8::gemm_phase<pg8::EpiRes, pg8::StaticOrder, false, true>(F.lds, g, S, E);
#endif


#ifndef SKIP_SG
 REFRESH(); if (!rep) { if (F.G == 256) sample_kreduce(F, (unsigned*)(F.ws + WS_CTL) + CW_SUB + 64 * (2 * l + 1), bar.bar); else sample_gemm_phase(F, 4, l, F.bid, 64); }
#endif

        } SEAM(base + 7);
    }

#ifndef SKIP_PF
 if (IN(17)) { REFRESH(); p_final(F); }
#endif

#undef IN
#undef SEAM
}

static void mk_forward(void* const* d_in, float* out, void* d_ws, hipStream_t stream, int per_phase) {
    static int ready = 0;
    if (!ready) { hipFuncSetAttribute((const void*)mk_fwd, hipFuncAttributeMaxDynamicSharedMemorySize, mk::LDS_BYTES); ready = 1; }
    hipMemsetAsync((char*)d_ws + mk::WS_CTL, 0, mk::CTL_ZERO_BYTES, stream);
    mk::Args a{};
    for (int i = 0; i < 20; ++i) a.in[i] = (const float*)d_in[i];
    a.out = out; a.ws = (unsigned char*)d_ws;
#ifdef REP_MASK
    a.rep_mask = REP_MASK;
#endif
    if (per_phase) { for (int p = 0; p < N_PHASES; ++p) { a.ph_lo = p; a.ph_hi = p + 1; hipLaunchKernelGGL(mk_fwd, dim3(256), dim3(mk::NTHR), mk::LDS_BYTES, stream, a); } }
    else { a.ph_lo = 0; a.ph_hi = N_PHASES; hipLaunchKernelGGL(mk_fwd, dim3(256), dim3(mk::NTHR), mk::LDS_BYTES, stream, a); }
}
#ifndef MK_PER_PHASE
#define MK_PER_PHASE 0
#endif
extern "C" void kernel_launch(void* const* d_in, const int* in_sizes, int n_in, void* d_out, int out_size, void* d_ws, size_t ws_size, hipStream_t stream) {
    if (n_in != 20 || out_size != (int)cfg::O_END || ws_size < mk::WS_END + (2u << 20)) { fprintf(stderr, "kernel_launch: unexpected shapes n_in %d out %d ws %zu\n", n_in, out_size, ws_size); return; }
    mk_forward(d_in, (float*)d_out, d_ws, stream, MK_PER_PHASE);
}
```

```cpp
#include <hip/hip_runtime.h>
#include <cstdio>
#include <cstdint>
#include <cmath>
namespace cfg {
constexpr int DM = 2048, BATCH = 4, SEQ = 2048, DEPTH = 2, DB = 32, DFF = 5632, NCOL = 5632, NUP = 11264;
constexpr int MP = BATCH * SEQ;
constexpr float EPS = 1e-6f;
constexpr int C_QA = 0, C_FA = 512, C_IA = 1024, C_GA = 1536, C_QB = 2048, C_KB = 3072, C_VB = 3328, C_QC = 3584, C_KC = 4096, C_VC = 4608, C_GC = 5120;
constexpr size_t O_YP = 0, O_YS = 16777216, O_PHGRN = 16842752, O_PK = 17367040, O_PV = 17629184, O_PRET = 17891328, O_PCONV = 18415616,
                 O_SHGRN = 18595840, O_SK = 22790144, O_SV = 24887296, O_SRET = 26984448, O_SCONV = 31178752, O_END = 32620544;
}
__device__ __forceinline__ unsigned opq_u32(unsigned x) { asm volatile("" : "+v"(x)); return x; }
__device__ __forceinline__ unsigned long long opq_u64(unsigned long long x) { asm volatile("" : "+s"(x)); return x; }
namespace pg8 {
#define PG8_LAS __attribute__((address_space(3)))
typedef unsigned short bf16_t;
typedef short bf16x8 __attribute__((ext_vector_type(8)));
typedef float f32x4 __attribute__((ext_vector_type(4)));
typedef float f32x2 __attribute__((ext_vector_type(2)));
typedef unsigned u32x4 __attribute__((ext_vector_type(4)));
constexpr int BM = 256, BK = 64, HALF = 128, HTB = HALF * BK * 2  , STAGE_BYTES = 8 * HTB, NXCD = 8, WGM = 4;

__host__ __device__ __forceinline__ int lds_byte(int r, int c) { const int st = (r >> 4) * 2 + (c >> 5), rr = r & 15, cc = c & 31, ob = rr * 64 + cc * 2; return st * 1024 + (ob ^ (((ob >> 9) & 1) << 5)); }
__host__ __device__ __forceinline__ void stage_rc(int b, int& R, int& C) { const int st = b / 1024, sb = b % 1024, swz = sb ^ (((sb >> 9) & 1) << 5); R = (st >> 1) * 16 + swz / 64; C = (st & 1) * 32 + (swz % 64) / 2; }
__host__ __device__ __forceinline__ int perm32(int rho) { const int n = rho >> 4, i = rho & 15; return 8 * (i >> 2) + 4 * n + (i & 3); }

struct Unit { int pm, pn; };
struct Gemm { const bf16_t* A; const bf16_t* Bt; int M, N, K; };

struct StaticOrder {
    int nM, nN, nwg, G, c;
    __host__ __device__ void init(int M, int N, int G_, int c_) { nM = M / BM; nN = N / BM; nwg = nM * nN; G = G_; c = c_; }
    __host__ __device__ bool next(int i, Unit& u) const {
        const long L = (long)i * G + c; if (L >= nwg) return false;
        int wgid = (int)L; { const int q = nwg / NXCD, r = nwg % NXCD, xcd = wgid % NXCD, off = wgid / NXCD; wgid = (xcd < r ? xcd * (q + 1) : r * (q + 1) + (xcd - r) * q) + off; }
        const int nig = WGM * nN, gid = wgid / nig, fm = gid * WGM, gsz = (nM - fm) < WGM ? (nM - fm) : WGM;
        u.pm = fm + ((wgid % nig) % gsz); u.pn = (wgid % nig) / gsz; return true;
    }
    __device__ __forceinline__ void a_ready(const Unit&) const {}
    __device__ __forceinline__ void done(const Unit&) const {}
};

struct InProjOrder {
    StaticOrder so; int c;
    __host__ __device__ void init(int M, int  , int G_, int c_) { so.init(M, 20 * BM, G_, c_); c = c_; }
    __host__ __device__ bool next(int i, Unit& u) const {
        if (so.G != 256) { StaticOrder full; full.init(so.nM * BM, 22 * BM, so.G, c); return full.next(i, u); }
        const int L = i * 256 + c; if (L >= 704) return false;
        if (L >= 448 && L < 512) { const int f = L - 448, x = f & 7, j = f >> 3; u.pm = 4 * x + (j & 3); u.pn = 2 + (j >> 2); return true; }
        StaticOrder t = so; t.c = c - (L >= 512 ? 64 : 0); if (!t.next(i, u)) return false;
        u.pn = u.pn < 2 ? u.pn : u.pn + 2; return true;
    }
    __device__ __forceinline__ void a_ready(const Unit&) const {}
    __device__ __forceinline__ void done(const Unit&) const {}
};

__device__ __forceinline__ unsigned cvt_pk_bf16(float lo, float hi) { unsigned r; asm volatile("v_cvt_pk_bf16_f32 %0, %1, %2" : "=v"(r) : "v"(lo), "v"(hi)); return r; }
__device__ __forceinline__ float row_rstd(const float* SS, int row) {
    const f32x4 a = *(const f32x4*)(SS + (size_t)row * 8), b = *(const f32x4*)(SS + (size_t)row * 8 + 4);
    const float s = ((a[0] + a[1]) + (a[2] + a[3])) + ((b[0] + b[1]) + (b[2] + b[3]));
    return 1.0f / sqrtf(s * (1.0f / 2048.0f) + 1e-6f);
}
__device__ __forceinline__ void fgate(float fa, float lb, float& ka, float& lf) {
    const float e = __builtin_amdgcn_exp2f(-1.4426950408889634f * fabsf(fa)), inv = __builtin_amdgcn_rcpf(1.0f + e);
    const float s = fa >= 0.f ? inv : e * inv, sm = fa >= 0.f ? e * inv : inv;
    ka = (1.0f - lb) * sm; lf = 0.6931471805599453f * __builtin_amdgcn_logf(lb + (1.0f - lb) * s);
}
struct EpiZ {
    static constexpr bool PERM = true, AFTER_DRAIN = false, HAS_NOSTORE = true;
    bf16_t* Z; float* LOGF; const float* SS; const float* lbraw; int layer; int ldz; PG8_LAS float* rsl;
    __device__ __forceinline__ void operator()(const f32x4 (&acc)[2][2][4][2], const Unit& u, int wr, int wc, int fr, int fq) const {
        const int row0 = u.pm * BM + wr * 64 + fr, col0 = u.pn * BM + wc * 32 + 8 * fq;
        const bool isF = (u.pn == 2 || u.pn == 3);
        { const int t = (int)opq_u32(threadIdx.x); if (t < 256) rsl[t] = row_rstd(SS, u.pm * BM + t);
          else if (isF) { const int c = u.pn * BM + (t - 256) - 512; rsl[t] = layer == 1 ? __builtin_amdgcn_rcpf(1.0f + __builtin_amdgcn_exp2f(1.4426950408889634f * (lbraw[c] - lbraw[512 + c]))) : 0.f; } }
        asm volatile("s_waitcnt vmcnt(0) lgkmcnt(0)" ::: "memory"); __builtin_amdgcn_s_barrier(); asm volatile("" ::: "memory");
#pragma unroll
        for (int ai = 0; ai < 2; ++ai)
#pragma unroll
            for (int m = 0; m < 4; ++m) { const int row = row0 + ai * HALF + m * 16; const float r = rsl[ai * HALF + wr * 64 + m * 16 + fr]; bf16_t* rowp = Z + (size_t)row * ldz + col0;
#pragma unroll
                for (int bj = 0; bj < 2; ++bj) { f32x4 v0 = acc[ai][bj][m][0] * r, v1 = acc[ai][bj][m][1] * r;
                    if (isF) { f32x4 l0, l1;
                        const f32x4 lb0 = *(const PG8_LAS f32x4*)(rsl + 256 + wc * 32 + 8 * fq + bj * HALF), lb1 = *(const PG8_LAS f32x4*)(rsl + 256 + wc * 32 + 8 * fq + bj * HALF + 4);
#pragma unroll
                        for (int j = 0; j < 4; ++j) { float ka, lf; const float lba = lb0[j], lbb = lb1[j];
                            fgate(v0[j], lba, ka, lf); v0[j] = ka; l0[j] = lf; fgate(v1[j], lbb, ka, lf); v1[j] = ka; l1[j] = lf; }
                        float* lp = LOGF + (size_t)row * 512 + (col0 + bj * HALF - 512); *(f32x4*)lp = l0; *(f32x4*)(lp + 4) = l1; }
                    u32x4 w; w.x = cvt_pk_bf16(v0[0], v0[1]); w.y = cvt_pk_bf16(v0[2], v0[3]); w.z = cvt_pk_bf16(v1[0], v1[1]); w.w = cvt_pk_bf16(v1[2], v1[3]);
                    *(u32x4*)(rowp + bj * HALF) = w; } }
    }
};
struct EpiU {
    static constexpr bool PERM = true, AFTER_DRAIN = false, HAS_NOSTORE = false;
    bf16_t* U; const float* SS; int ldu;
    __device__ __forceinline__ void operator()(const f32x4 (&acc)[2][2][4][2], const Unit& u, int wr, int wc, int fr, int fq) const {
        const int row0 = u.pm * BM + wr * 64 + fr, col0 = u.pn * BM + wc * 32 + 8 * fq;
#pragma unroll
        for (int ai = 0; ai < 2; ++ai)
#pragma unroll
            for (int m = 0; m < 4; ++m) { const int row = row0 + ai * HALF + m * 16; const float r = row_rstd(SS, row); bf16_t* rowp = U + (size_t)row * ldu + col0;
#pragma unroll
                for (int bj = 0; bj < 2; ++bj) { const f32x4 v0 = acc[ai][bj][m][0] * r, v1 = acc[ai][bj][m][1] * r;
                    u32x4 w; w.x = cvt_pk_bf16(v0[0], v0[1]); w.y = cvt_pk_bf16(v0[2], v0[3]); w.z = cvt_pk_bf16(v1[0], v1[1]); w.w = cvt_pk_bf16(v1[2], v1[3]);
                    *(u32x4*)(rowp + bj * HALF) = w; }
                asm volatile("" ::: "memory"); }
    }
};

struct EpiUF {
    static constexpr bool PERM = true, AFTER_DRAIN = false, HAS_NOSTORE = false;
    bf16_t* HF; float* UH; const float* SS; const float* cw; const float* cb; PG8_LAS float* halo;
    __device__ __forceinline__ float rstd_fast(int row) const { const unsigned o = (unsigned)row * 32u; const f32x4 a = *(const f32x4*)((const char*)SS + o), b = *(const f32x4*)((const char*)SS + o + 16);
        return __builtin_amdgcn_rsqf((((a[0] + a[1]) + (a[2] + a[3])) + ((b[0] + b[1]) + (b[2] + b[3]))) * (1.0f / 2048.0f) + 1e-6f); }
    template <int CTRL> static __device__ __forceinline__ float dpp(float old, float x) { return __builtin_bit_cast(float, __builtin_amdgcn_update_dpp(__builtin_bit_cast(int, old), __builtin_bit_cast(int, x), CTRL, 0xf, 0xf, false)); }
    template <int CTRL> static __device__ __forceinline__ float dppz(float x) { return __builtin_bit_cast(float, __builtin_amdgcn_update_dpp(0, __builtin_bit_cast(int, x), CTRL, 0xf, 0xf, true)); }
    __device__ __forceinline__ float gelu(float x) const { const float t = 0.7978845608028654f * (x + 0.044715f * x * x * x); return x * __builtin_amdgcn_rcpf(1.0f + __builtin_amdgcn_exp2f(-2.8853900817779268f * t)); }
    __device__ __forceinline__ void operator()(const f32x4 (&acc)[2][2][4][2], const Unit& u, int wr_, int wc_, int fr_, int fq_) const {
        const int tid_ = (int)opq_u32(threadIdx.x), wid_ = __builtin_amdgcn_readfirstlane(tid_ >> 6), wr = wid_ >> 2, wc = wid_ & 3, fr = tid_ & 15, fq = (tid_ >> 4) & 3;
                const int row0 = u.pm * BM + wr * 64 + fr, ct0 = wc * 32 + 8 * fq;
        float* uh = UH + (size_t)(u.pm * 44 + u.pn) * 1024;
        { const float r00 = rstd_fast(row0);
#pragma unroll
        for (int ai = 0; ai < 2; ++ai) { const float r3 = rstd_fast(row0 + ai * HALF + 48);
#pragma unroll
            for (int bj = 0; bj < 2; ++bj)
#pragma unroll
                for (int n = 0; n < 2; ++n) { const int ct = bj * HALF + ct0 + 4 * n;
                    if (fr >= 14) { const f32x4 v = acc[ai][bj][3][n] * r3; *(PG8_LAS f32x4*)(halo + ((2 * ai + wr) * 2 + (fr - 14)) * 256 + ct) = v;
                        if (ai == 1 && wr == 1) *(f32x4*)(uh + (2 + fr - 14) * 256 + ct) = v; }
                    if (fr < 2 && ai == 0 && wr == 0) *(f32x4*)(uh + fr * 256 + ct) = acc[0][bj][0][n] * r00; } } }
        PG8_LAS float* WL = halo + 2048; PG8_LAS float* RSL = halo + 3072;
#pragma unroll
        for (int q = 0; q < 2; ++q) { const int idx = tid_ + 512 * q, kind = idx >> 8, ct = idx & 255, col = (ct >> 7) * 5632 + u.pn * HALF + (ct & 127);
            WL[idx] = kind < 3 ? cw[kind * 11264 + col] : cb[col]; }
        if (tid_ < 256) RSL[tid_] = rstd_fast(u.pm * BM + tid_);
        asm volatile("s_waitcnt vmcnt(0) lgkmcnt(0)" ::: "memory"); __builtin_amdgcn_s_barrier(); asm volatile("" ::: "memory");
#pragma unroll
        for (int ai = 0; ai < 2; ++ai) { const int k = 2 * ai + wr;
            __builtin_amdgcn_sched_barrier(0);
            float rs4[4];
#pragma unroll
            for (int m = 0; m < 4; ++m) rs4[m] = RSL[ai * HALF + wr * 64 + m * 16 + fr];
            __builtin_amdgcn_sched_barrier(0);
            unsigned outp[4][4];
#pragma unroll
            for (int n = 0; n < 2; ++n) {
                float val[4][4];
#pragma unroll
                for (int bj = 1; bj >= 0; --bj) {
                    const int wo = bj * HALF + ct0 + 4 * n;
                    const f32x4 W0 = *(const PG8_LAS f32x4*)(WL + wo), W1 = *(const PG8_LAS f32x4*)(WL + 256 + wo), W2 = *(const PG8_LAS f32x4*)(WL + 512 + wo), Bv = *(const PG8_LAS f32x4*)(WL + 768 + wo);
                    f32x4 h0 = (f32x4){0.f, 0.f, 0.f, 0.f}, h1 = h0;
                    if (k > 0) { h0 = *(const PG8_LAS f32x4*)(halo + ((k - 1) * 2 + 0) * 256 + bj * HALF + ct0 + 4 * n); h1 = *(const PG8_LAS f32x4*)(halo + ((k - 1) * 2 + 1) * 256 + bj * HALF + ct0 + 4 * n); }
#pragma unroll
                    for (int jp = 0; jp < 2; ++jp) {
                        const f32x2 W0p = {W0[2 * jp], W0[2 * jp + 1]}, W1p = {W1[2 * jp], W1[2 * jp + 1]}, W2p = {W2[2 * jp], W2[2 * jp + 1]}, Bp = {Bv[2 * jp], Bv[2 * jp + 1]};
                        f32x2 c1 = {h1[2 * jp], h1[2 * jp + 1]}, c2 = fr == 0 ? (f32x2){h0[2 * jp], h0[2 * jp + 1]} : c1;
#pragma unroll
                        for (int m = 0; m < 4; ++m) { const f32x2 a2 = {acc[ai][bj][m][n][2 * jp], acc[ai][bj][m][n][2 * jp + 1]}; const f32x2 um = a2 * rs4[m];
                            const f32x2 p1 = {dpp<0x111>(c1.x, um.x), dpp<0x111>(c1.y, um.y)}, p2 = {dpp<0x112>(c2.x, um.x), dpp<0x112>(c2.y, um.y)};
                            const f32x2 cv = __builtin_elementwise_fma(W0p, p2, __builtin_elementwise_fma(W1p, p1, __builtin_elementwise_fma(W2p, um, Bp)));
                            c1 = (f32x2){dppz<0x10F>(um.x), dppz<0x10F>(um.y)}; c2 = (f32x2){dppz<0x10E>(um.x), dppz<0x10E>(um.y)};
                            if (bj == 1) { val[m][2 * jp] = cv.x; val[m][2 * jp + 1] = cv.y; }
                            else { const f32x2 x2 = cv * cv, t = cv * __builtin_elementwise_fma(x2, (f32x2){0.7978845608028654f * 0.044715f * -2.8853900817779268f, 0.7978845608028654f * 0.044715f * -2.8853900817779268f}, (f32x2){0.7978845608028654f * -2.8853900817779268f, 0.7978845608028654f * -2.8853900817779268f});
                                const f32x2 d = (f32x2){__builtin_amdgcn_exp2f(t.x), __builtin_amdgcn_exp2f(t.y)} + 1.0f; const f32x2 ge = cv * (f32x2){__builtin_amdgcn_rcpf(d.x), __builtin_amdgcn_rcpf(d.y)} * (f32x2){val[m][2 * jp], val[m][2 * jp + 1]};
                                outp[m][2 * n + jp] = cvt_pk_bf16(ge.x, ge.y); } }
                        __builtin_amdgcn_sched_barrier(0); } } }
#pragma unroll
            for (int m = 0; m < 4; ++m) { u32x4 w; w.x = outp[m][0]; w.y = outp[m][1]; w.z = outp[m][2]; w.w = outp[m][3];
                *(u32x4*)((char*)HF + ((unsigned)(row0 + ai * HALF + m * 16) * 5632u + (unsigned)(u.pn * HALF + ct0)) * 2u) = w; } }
    }
};
struct EpiRes {
    static constexpr bool PERM = true, AFTER_DRAIN = true, HAS_NOSTORE = false;
    const float* XR; const bf16_t* XBi; bf16_t* XB; float* SSo;
    __device__ __forceinline__ void fused(const f32x4 (&acc)[2][2][4][2], const Unit& u, int wr, int wc, int fr, int fq, PG8_LAS unsigned char* lds, int wid, int lane) const {
        PG8_LAS float* P = (PG8_LAS float*)lds;
        const int row0 = u.pm * BM + wr * 64 + fr, col0 = u.pn * BM + wc * 32 + 8 * fq;
#pragma unroll
        for (int ai = 0; ai < 2; ++ai)
#pragma unroll
        for (int mh = 0; mh < 1; ++mh) {
            u32x4 ra[4][2], rb[4][2];
#pragma unroll
            for (int mm = 0; mm < 4; ++mm) { const size_t off = (size_t)(row0 + ai * HALF + mm * 16) * 2048 + col0;
#pragma unroll
                for (int bj = 0; bj < 2; ++bj) { if (XR) { ra[mm][bj] = *(const u32x4*)(XR + off + bj * HALF); rb[mm][bj] = *(const u32x4*)(XR + off + bj * HALF + 4); }
                    else { ra[mm][bj] = *(const u32x4*)(XBi + off + bj * HALF); rb[mm][bj] = ra[mm][bj]; } } }
#pragma unroll
            for (int mm = 0; mm < 4; ++mm) { const int m = mm; const size_t off = (size_t)(row0 + ai * HALF + m * 16) * 2048 + col0; float q = 0.f;
#pragma unroll
                for (int bj = 0; bj < 2; ++bj) { f32x4 x0, x1;
                    if (XR) { x0 = __builtin_bit_cast(f32x4, ra[mm][bj]); x1 = __builtin_bit_cast(f32x4, rb[mm][bj]); }
                    else { const u32x4 h = ra[mm][bj];
                        x0[0] = __uint_as_float(h.x << 16); x0[1] = __uint_as_float(h.x & 0xffff0000u); x0[2] = __uint_as_float(h.y << 16); x0[3] = __uint_as_float(h.y & 0xffff0000u);
                        x1[0] = __uint_as_float(h.z << 16); x1[1] = __uint_as_float(h.z & 0xffff0000u); x1[2] = __uint_as_float(h.w << 16); x1[3] = __uint_as_float(h.w & 0xffff0000u); }
                    const f32x4 v0 = x0 + acc[ai][bj][m][0], v1 = x1 + acc[ai][bj][m][1];
                    u32x4 w; w.x = cvt_pk_bf16(v0[0], v0[1]); w.y = cvt_pk_bf16(v0[2], v0[3]); w.z = cvt_pk_bf16(v1[0], v1[1]); w.w = cvt_pk_bf16(v1[2], v1[3]);
                    *(u32x4*)(XB + off + bj * HALF) = w;
                    q += ((v0[0] * v0[0] + v0[1] * v0[1]) + (v0[2] * v0[2] + v0[3] * v0[3])) + ((v1[0] * v1[0] + v1[1] * v1[1]) + (v1[2] * v1[2] + v1[3] * v1[3])); }
                q += __shfl_xor(q, 16); q += __shfl_xor(q, 32);
                if (fq == 0) P[(ai * HALF + wr * 64 + m * 16 + fr) * 4 + wc] = q; }
            asm volatile("" ::: "memory"); }
        asm volatile("s_waitcnt lgkmcnt(0)" ::: "memory"); __builtin_amdgcn_s_barrier(); asm volatile("" ::: "memory");
        const int t = wid * 64 + lane;
        if (t < 256) { const PG8_LAS f32x4* p4 = (const PG8_LAS f32x4*)P; const f32x4 a = p4[t]; SSo[(size_t)(u.pm * BM + t) * 8 + u.pn] = (a[0] + a[1]) + (a[2] + a[3]); }
        asm volatile("s_waitcnt lgkmcnt(0)" ::: "memory"); __builtin_amdgcn_s_barrier(); asm volatile("" ::: "memory");
    }
};
template <class Epi, class Sched, bool ALIGN_EPI = false, bool SP2 = false>
__device__ __forceinline__ void gemm_phase(PG8_LAS unsigned char* lds, const Gemm g, const Sched& S, const Epi& E) {
    const int tid = (int)opq_u32(threadIdx.x), wid = __builtin_amdgcn_readfirstlane(tid >> 6), lane = tid & 63, wr = wid >> 2, wc = wid & 3, fr = lane & 15, fq = lane >> 4;
    const int K = g.K, nt = K / BK;
    unsigned voffA[2], voffB[2];
#pragma unroll
    for (int i = 0; i < 2; ++i) { int R, C; stage_rc(tid * 16 + i * 8192, R, C); const int Rb = Epi::PERM ? ((R & ~31) + perm32(R & 31)) : R;
        voffA[i] = (unsigned)(R * K + C) * 2u; voffB[i] = (unsigned)(Rb * K + C) * 2u; }
    const size_t kstep = (size_t)(BK * 2);
    const size_t hstep = (size_t)HALF * K * 2;
    const size_t tstep = 2 * hstep;
    const unsigned ldsw = (unsigned)wid * 1024u;
    const int aoff = lds_byte(wr * 64 + fr, fq * 8), boff = lds_byte(wc * 32 + fr, fq * 8);
#define PG8_SA(b, h) (((b) * 2 + (h)) * HTB)
#define PG8_SB(b, h) ((4 + (b) * 2 + (h)) * HTB)
#define PG8_STAGE(bufoff, gbase, voff) do { _Pragma("unroll") for (int _i = 0; _i < 2; ++_i) \
        __builtin_amdgcn_global_load_lds((const unsigned*)((const char*)(gbase) + (voff)[_i]), (PG8_LAS unsigned*)(lds + (bufoff) + ldsw + _i * 8192), 16, 0, 0); } while (0)
#define PG8_LDA(dst, b, h) do { _Pragma("unroll") for (int m = 0; m < 4; ++m) _Pragma("unroll") for (int k = 0; k < 2; ++k) dst[m][k] = *(const PG8_LAS bf16x8*)(lds + PG8_SA(b, h) + aoff + m * 2048 + k * 1024); } while (0)
#define PG8_LDB(dst, b, h) do { _Pragma("unroll") for (int n = 0; n < 2; ++n) _Pragma("unroll") for (int k = 0; k < 2; ++k) dst[n][k] = *(const PG8_LAS bf16x8*)(lds + PG8_SB(b, h) + boff + n * 2048 + k * 1024); } while (0)
#define PG8_MMA(ai, bj, At, Bt) do { __builtin_amdgcn_s_setprio(1); _Pragma("unroll") for (int m = 0; m < 4; ++m) _Pragma("unroll") for (int n = 0; n < 2; ++n) _Pragma("unroll") for (int k = 0; k < 2; ++k) \
        acc[ai][bj][m][n] = __builtin_amdgcn_mfma_f32_16x16x32_bf16(Bt[n][k], At[m][k], acc[ai][bj][m][n], 0, 0, 0); __builtin_amdgcn_s_setprio(0); } while (0)
#define PG8_WAIT_V(n) asm volatile("s_waitcnt vmcnt(" #n ")" ::: "memory")
#define PG8_WAIT_L(n) asm volatile("s_waitcnt lgkmcnt(" #n ")" ::: "memory")
#define PG8_BAR __builtin_amdgcn_s_barrier()
#define PG8_SCHED __builtin_amdgcn_sched_barrier(0)
    Unit cur, nxt; int ui = 0;
    if (!S.next(0, cur)) return;
    f32x4 acc[2][2][4][2];
#pragma unroll
    for (int a = 0; a < 2; ++a)
#pragma unroll
        for (int b = 0; b < 2; ++b)
#pragma unroll
            for (int m = 0; m < 4; ++m)
#pragma unroll
                for (int n = 0; n < 2; ++n) acc[a][b][m][n] = (f32x4){0.f, 0.f, 0.f, 0.f};
    bf16x8 At[4][2], B0[2][2], B1[2][2];
    const char* cA = (const char*)g.A + (size_t)cur.pm * tstep; const char* cB = (const char*)g.Bt + (size_t)cur.pn * tstep;
    S.a_ready(cur);
    if constexpr (SP2) {
        PG8_STAGE(PG8_SB(0, 0), cB, voffB); PG8_STAGE(PG8_SB(0, 1), cB + hstep, voffB); PG8_STAGE(PG8_SA(0, 0), cA, voffA); PG8_STAGE(PG8_SA(0, 1), cA + hstep, voffA);
        if (wr == 1) PG8_BAR;
        PG8_WAIT_V(2); PG8_BAR;
        PG8_STAGE(PG8_SB(1, 0), cB + kstep, voffB); PG8_STAGE(PG8_SA(1, 0), cA + kstep, voffA); PG8_STAGE(PG8_SB(1, 1), cB + hstep + kstep, voffB);
        PG8_WAIT_V(6); PG8_BAR;
    } else {
        PG8_STAGE(PG8_SB(0, 0), cB, voffB); PG8_STAGE(PG8_SA(0, 0), cA, voffA); PG8_STAGE(PG8_SB(0, 1), cB + hstep, voffB); PG8_STAGE(PG8_SA(0, 1), cA + hstep, voffA);
        if (wr == 1) PG8_BAR;
        PG8_WAIT_V(4); PG8_BAR;
        PG8_STAGE(PG8_SB(1, 0), cB + kstep, voffB); PG8_STAGE(PG8_SA(1, 0), cA + kstep, voffA); PG8_STAGE(PG8_SB(1, 1), cB + hstep + kstep, voffB);
        PG8_WAIT_V(6); PG8_BAR;
    }
    for (;;) {
        const bool has_next = S.next(ui + 1, nxt);
        const char* nA = has_next ? (const char*)g.A + (size_t)nxt.pm * tstep : cA; const char* nB = has_next ? (const char*)g.Bt + (size_t)nxt.pn * tstep : cB;
        for (int t = 0; t < nt; t += 2) {
            const bool last = (t == nt - 2);
            const char* a1 = cA + (size_t)(t + 1) * kstep;
            const char* a2 = last ? nA : cA + (size_t)(t + 2) * kstep; const char* b2 = last ? nB : cB + (size_t)(t + 2) * kstep;
            const char* a3 = a2 + kstep; const char* b3 = b2 + kstep;
            if (last && has_next) S.a_ready(nxt);
            if constexpr (SP2) {
            PG8_LDB(B0, 0, 0); PG8_LDB(B1, 0, 1); PG8_SCHED; PG8_LDA(At, 0, 0); PG8_STAGE(PG8_SA(1, 1), a1 + hstep, voffA);
            PG8_WAIT_V(8); PG8_WAIT_L(0); PG8_BAR; PG8_MMA(0, 0, At, B0); PG8_MMA(0, 1, At, B1); PG8_BAR; PG8_SCHED;
            PG8_LDA(At, 0, 1); PG8_STAGE(PG8_SB(0, 0), b2, voffB); PG8_STAGE(PG8_SB(0, 1), b2 + hstep, voffB); PG8_STAGE(PG8_SA(0, 0), a2, voffA);
            PG8_WAIT_V(8); PG8_WAIT_L(0); PG8_BAR; PG8_MMA(1, 0, At, B0); PG8_MMA(1, 1, At, B1); PG8_BAR; PG8_SCHED;
            PG8_LDB(B0, 1, 0); PG8_LDB(B1, 1, 1); PG8_SCHED; PG8_LDA(At, 1, 0); PG8_STAGE(PG8_SA(0, 1), a2 + hstep, voffA);
            PG8_WAIT_V(8); PG8_WAIT_L(0); PG8_BAR; PG8_MMA(0, 0, At, B0); PG8_MMA(0, 1, At, B1); PG8_BAR; PG8_SCHED;
            PG8_LDA(At, 1, 1); PG8_STAGE(PG8_SB(1, 0), b3, voffB); PG8_STAGE(PG8_SB(1, 1), b3 + hstep, voffB); PG8_STAGE(PG8_SA(1, 0), a3, voffA);
            PG8_WAIT_V(8); PG8_WAIT_L(0); PG8_BAR; PG8_MMA(1, 0, At, B0); PG8_MMA(1, 1, At, B1); PG8_BAR; PG8_SCHED;
            } else {
            PG8_LDB(B0, 0, 0); PG8_SCHED; PG8_LDA(At, 0, 0); PG8_STAGE(PG8_SA(1, 1), a1 + hstep, voffA);
            PG8_WAIT_L(8); PG8_BAR; PG8_WAIT_L(0); PG8_MMA(0, 0, At, B0); PG8_BAR; PG8_SCHED;
            PG8_LDB(B1, 0, 1); PG8_STAGE(PG8_SB(0, 0), b2, voffB);
            PG8_BAR; PG8_WAIT_L(0); PG8_MMA(0, 1, At, B1); PG8_BAR;
            PG8_LDA(At, 0, 1); PG8_STAGE(PG8_SA(0, 0), a2, voffA);
            PG8_BAR; PG8_WAIT_L(0); PG8_MMA(1, 0, At, B0); PG8_BAR; PG8_SCHED;
            PG8_STAGE(PG8_SB(0, 1), b2 + hstep, voffB);
            PG8_WAIT_V(6); PG8_BAR; PG8_MMA(1, 1, At, B1); PG8_BAR;
            PG8_LDB(B0, 1, 0); PG8_SCHED; PG8_LDA(At, 1, 0); PG8_STAGE(PG8_SA(0, 1), a2 + hstep, voffA);
            PG8_WAIT_L(8); PG8_BAR; PG8_WAIT_L(0); PG8_MMA(0, 0, At, B0); PG8_BAR; PG8_SCHED;
            PG8_LDB(B1, 1, 1); PG8_STAGE(PG8_SB(1, 0), b3, voffB);
            PG8_BAR; PG8_WAIT_L(0); PG8_MMA(0, 1, At, B1); PG8_BAR;
            PG8_LDA(At, 1, 1); PG8_STAGE(PG8_SA(1, 0), a3, voffA);
            PG8_BAR; PG8_WAIT_L(0); PG8_MMA(1, 0, At, B0); PG8_BAR; PG8_SCHED;
            PG8_STAGE(PG8_SB(1, 1), b3 + hstep, voffB);
            PG8_WAIT_V(6); PG8_BAR; PG8_MMA(1, 1, At, B1); PG8_BAR;
            }
        }
        if constexpr (ALIGN_EPI) { if (wr == 0) PG8_BAR; }
        if constexpr (!Epi::AFTER_DRAIN) { E(acc, cur, wr, wc, fr, fq);
#ifdef REP_EPI
            asm volatile("" ::: "memory"); E(acc, cur, wr, wc, fr, fq);
#endif
#ifdef REP_EPI_NOSTORE
            if constexpr (Epi::HAS_NOSTORE) { asm volatile("" ::: "memory"); Epi E2 = E; E2.Z = (decltype(E2.Z))opq_u64(0); E2(acc, cur, wr, wc, fr, fq); }
#endif
            S.done(cur); }
        if (!has_next) break;
#pragma unroll
        for (int a = 0; a < 2; ++a)
#pragma unroll
            for (int b = 0; b < 2; ++b)
#pragma unroll
                for (int m = 0; m < 4; ++m)
#pragma unroll
                    for (int n = 0; n < 2; ++n) acc[a][b][m][n] = (f32x4){0.f, 0.f, 0.f, 0.f};
        cur = nxt; cA = nA; cB = nB; ++ui;
        if constexpr (ALIGN_EPI) { if (wr == 1) PG8_BAR; }
    }
    PG8_WAIT_V(0);
    if constexpr (!ALIGN_EPI) { if (wr == 0) PG8_BAR; }
    PG8_BAR;
    if constexpr (Epi::AFTER_DRAIN) { E.fused(acc, cur, wr, wc, fr, fq, lds, wid, lane); S.done(cur); }
#undef PG8_SA
#undef PG8_SB
#undef PG8_STAGE
#undef PG8_LDA
#undef PG8_LDB
#undef PG8_MMA
#undef PG8_WAIT_V
#undef PG8_WAIT_L
#undef PG8_BAR
#undef PG8_SCHED
}
}
#define GAS __attribute__((address_space(1)))
#define LAS __attribute__((address_space(3)))
namespace mk {
using namespace cfg;
typedef unsigned short bf16;
typedef float f32x4 __attribute__((ext_vector_type(4)));
typedef float f32x2 __attribute__((ext_vector_type(2)));
typedef float f32x16 __attribute__((ext_vector_type(16)));
typedef short bf16x8 __attribute__((ext_vector_type(8)));
typedef short s16x4 __attribute__((ext_vector_type(4)));
typedef unsigned u32x4 __attribute__((ext_vector_type(4)));
typedef unsigned u32x2 __attribute__((ext_vector_type(2)));
constexpr int NWAVES = 8, NTHR = 512;
constexpr int LDS_BYTES = 163840;
constexpr int MISC_OFF = 163840 - 1024;
constexpr float LOG2E = 1.4426950408889634f;

#define LDS_WAIT() asm volatile("s_waitcnt lgkmcnt(0)" ::: "memory")
#define VM_WAIT() asm volatile("s_waitcnt vmcnt(0)" ::: "memory")
#define WG_BAR() do { asm volatile("s_waitcnt lgkmcnt(0)" ::: "memory"); __builtin_amdgcn_s_barrier(); asm volatile("" ::: "memory"); } while (0)
__device__ __forceinline__ unsigned pk2(float lo, float hi) { unsigned r; asm volatile("v_cvt_pk_bf16_f32 %0, %1, %2" : "=v"(r) : "v"(lo), "v"(hi)); return r; }
__device__ __forceinline__ float bf2f(unsigned short b) { return __uint_as_float(((unsigned)b) << 16); }
__device__ __forceinline__ float bflo(unsigned w) { return __uint_as_float(w << 16); }
__device__ __forceinline__ float bfhi(unsigned w) { return __uint_as_float(w & 0xffff0000u); }
__device__ __forceinline__ float wave_sum(float v) {
#pragma unroll
    for (int o = 1; o < 64; o <<= 1) v += __shfl_xor(v, o);
    return v;
}
__device__ __forceinline__ float wave_max(float v) {
#pragma unroll
    for (int o = 1; o < 64; o <<= 1) v = fmaxf(v, __shfl_xor(v, o));
    return v;
}
__device__ __forceinline__ float fexp2(float x) { return __builtin_amdgcn_exp2f(x); }
__device__ __forceinline__ float frcp(float x) { return __builtin_amdgcn_rcpf(x); }
__device__ __forceinline__ float silu(float x) { return x * frcp(1.0f + fexp2(-LOG2E * x)); }
__device__ __forceinline__ float gelu_tanh(float x) {
    const float u = 0.7978845608028654f * (x + 0.044715f * x * x * x);
    return x * frcp(1.0f + fexp2(-2.0f * LOG2E * u));
}
__device__ __forceinline__ unsigned off_b(unsigned row, unsigned ch) { return 256u * row + 16u * (ch ^ (((row & 3) << 2) | ((row >> 2) & 3))); }
__device__ __forceinline__ unsigned row_read_addr_16(unsigned lane, unsigned rb, unsigned s) { return off_b((lane & 15) + 16 * rb, 4 * s + (lane >> 4)); }
__device__ __forceinline__ unsigned tr_addr(unsigned lane, unsigned r0, unsigned c) { const unsigned q = (lane & 15) >> 2, p = lane & 3; return off_b(r0 + q, 2 * c + (p >> 1)) + 8 * (p & 1); }
__device__ __forceinline__ s16x4 tr_read(const LAS unsigned char* base, unsigned off) {
    typedef short v4i16 __attribute__((ext_vector_type(4)));
    return __builtin_bit_cast(s16x4, __builtin_amdgcn_ds_read_tr16_b64_v4i16((LAS v4i16*)(base + off)));
}
__device__ __forceinline__ bf16x8 cat8(s16x4 lo, s16x4 hi) { return __builtin_shufflevector(lo, hi, 0, 1, 2, 3, 4, 5, 6, 7); }
__device__ __forceinline__ bf16x8 lds_frag(const LAS unsigned char* base, unsigned off) { return *(const LAS bf16x8*)(base + off); }
#define MFMA16(a, b, c) __builtin_amdgcn_mfma_f32_16x16x32_bf16((a), (b), (c), 0, 0, 0)
#define MFMA32(a, b, c) __builtin_amdgcn_mfma_f32_32x32x16_bf16((a), (b), (c), 0, 0, 0)
__device__ __forceinline__ bf16x8 pack8(const f32x4& a, const f32x4& b) {
    u32x4 w; w.x = pk2(a[0], a[1]); w.y = pk2(a[2], a[3]); w.z = pk2(b[0], b[1]); w.w = pk2(b[2], b[3]); return __builtin_bit_cast(bf16x8, w);
}

constexpr size_t MiB = 1u << 20;
constexpr size_t WS_CTL = 0, CTL_ZERO_BYTES = 1 * MiB;
constexpr size_t SZ_WIN = (size_t)NCOL * DM * 2, SZ_WOUT = (size_t)DM * DM * 2, SZ_WUP = (size_t)NUP * DM * 2, SZ_WDN = (size_t)DM * DFF * 2;
constexpr size_t WS_WIN = 1 * MiB, WS_WOUT = WS_WIN + 2 * SZ_WIN, WS_WUP = WS_WOUT + 2 * SZ_WOUT, WS_WDN = WS_WUP + 2 * SZ_WUP;
constexpr size_t WS_X = WS_WDN + 2 * SZ_WDN;
constexpr size_t WS_XB = WS_X + (size_t)MP * DM * 4;
constexpr size_t WS_SS = WS_XB + (size_t)MP * DM * 2;
constexpr size_t WS_Z = WS_SS + (size_t)MP * 8 * 4;
constexpr size_t WS_HF = WS_Z;
constexpr size_t WS_LOGF = WS_Z + (size_t)MP * NCOL * 2;
constexpr size_t WS_MIX = WS_LOGF + (size_t)MP * 512 * 4;
constexpr size_t WS_U = WS_MIX + (size_t)MP * DM * 2;
constexpr size_t WS_XS = WS_U + (size_t)MP * NUP * 2;
constexpr size_t WS_XSB = WS_XS + (size_t)DB * DM * 4;
constexpr size_t WS_ZS = WS_XSB + (size_t)DB * DM * 2;
constexpr size_t WS_MIXS = WS_ZS + (size_t)DB * NCOL * 4;
constexpr size_t WS_US = WS_MIXS + (size_t)DB * DM * 2;
constexpr size_t WS_HFS = WS_US + (size_t)DB * NUP * 4;
constexpr size_t WS_END = WS_HFS + (size_t)DB * DFF * 2;
static_assert(WS_END <= (size_t)700 * MiB, "workspace map");
constexpr int CW_TMO = 0, CW_BAR = 4096, CW_SUB = 8192;
#define XB_TMO      128
#define XB_XCNT(j)  (256  + 64 * (j))
#define XB_XSUB(j)  (1280 + 64 * (j))
#define XB_XGEN(j)  (2304 + 64 * (j))
#define XB_TOP      3328
#define XB_TOPGEN   3392
#define XCD_BAR_WORDS 3456
#define XB_SPIN_CAP (1u << 18)

__device__ __forceinline__ unsigned xb_ld(unsigned* p)              { return __hip_atomic_load(p, __ATOMIC_RELAXED, __HIP_MEMORY_SCOPE_AGENT); }
__device__ __forceinline__ unsigned xb_add(unsigned* p, unsigned v) { return __hip_atomic_fetch_add(p, v, __ATOMIC_RELAXED, __HIP_MEMORY_SCOPE_AGENT); }
__device__ __forceinline__ unsigned xb_xcc_id() { return (unsigned)__builtin_amdgcn_s_getreg((3 << 11) | 20) & 0xFu; }
#define XB_SPIN(cond, bar) do { unsigned _sp = 0; while (cond) { __builtin_amdgcn_s_sleep(1); \
    if ((++_sp & 255u) == 0u) { if (xb_ld(&(bar)[XB_TMO])) break; if (_sp > XB_SPIN_CAP) { atomicAdd(&(bar)[XB_TMO], 1u); break; } } } } while (0)

struct XcdBarrier {
    unsigned* bar; unsigned x;
    volatile LAS unsigned* st;
};

__device__ __forceinline__ XcdBarrier xcd_barrier_post(unsigned* bar, volatile LAS unsigned* st) {
    XcdBarrier b; b.bar = bar; b.x = xb_xcc_id(); b.st = st;
    if (threadIdx.x == 0) (void)xb_add(&bar[XB_XCNT(b.x)], 1u);
    return b;
}
__device__ __forceinline__ void xcd_barrier_complete(unsigned* bar, unsigned x, unsigned& nloc, unsigned& nx) {
    const unsigned G = gridDim.x * gridDim.y * gridDim.z;
    unsigned sum, cnt, mine, sp = 0u;
    for (;;) {
        sum = 0u; cnt = 0u; mine = 0u;
#pragma unroll
        for (unsigned j = 0; j < 16; ++j) { const unsigned c = xb_ld(&bar[XB_XCNT(j)]); sum += c; cnt += (c > 0u) ? 1u : 0u; mine = (j == x) ? c : mine; }
        if (sum == G) break;
        __builtin_amdgcn_s_sleep(1);
        if ((++sp & 255u) == 0u) { if (xb_ld(&bar[XB_TMO])) break; if (sp > XB_SPIN_CAP) { atomicAdd(&bar[XB_TMO], 1u); break; } }
    }
    nloc = mine > 0u ? mine : 1u; nx = cnt > 0u ? cnt : 1u;
}

__device__ __forceinline__ void xcd_barrier(const XcdBarrier& b) {
    asm volatile("s_waitcnt vmcnt(0)" ::: "memory");
    __syncthreads();
    if (threadIdx.x == 0) {
        unsigned* bar = b.bar;
        __builtin_amdgcn_s_waitcnt(0);
        unsigned nloc = b.st[0], nx = b.st[1];
        if (nloc == 0u) { xcd_barrier_complete(bar, b.x, nloc, nx); b.st[0] = nloc; b.st[1] = nx; }
        const unsigned old = xb_add(&bar[XB_XSUB(b.x)], 1u);
        const unsigned gen = old / nloc;
        if (old + 1u == (gen + 1u) * nloc) {
            __builtin_amdgcn_fence(__ATOMIC_RELEASE, "agent");
            asm volatile("s_waitcnt vmcnt(0)" ::: "memory");
            const unsigned og = xb_add(&bar[XB_TOP], 1u);
            const unsigned tg = og / nx;
            if (og + 1u == (tg + 1u) * nx) xb_add(&bar[XB_TOPGEN], 1u);
            else XB_SPIN(xb_ld(&bar[XB_TOPGEN]) == tg, bar);
            __builtin_amdgcn_fence(__ATOMIC_ACQUIRE, "agent");
            xb_add(&bar[XB_XGEN(b.x)], 1u);
            asm volatile("s_waitcnt vmcnt(0)" ::: "memory");
        } else {
            XB_SPIN(xb_ld(&bar[XB_XGEN(b.x)]) == gen, bar);
            __builtin_amdgcn_fence(__ATOMIC_ACQUIRE, "agent");
            asm volatile("s_waitcnt vmcnt(0)" ::: "memory");
        }
    }
    __syncthreads();
}

__device__ __forceinline__ void sub_barrier(unsigned* ctr, unsigned target, unsigned* tmo_bar) {
    asm volatile("s_waitcnt vmcnt(0)" ::: "memory");
    __syncthreads();
    if (threadIdx.x == 0) {
        __builtin_amdgcn_s_waitcnt(0);
        __builtin_amdgcn_fence(__ATOMIC_RELEASE, "agent");
        asm volatile("s_waitcnt vmcnt(0)" ::: "memory");
        (void)xb_add(ctr, 1u);
        XB_SPIN(xb_ld(ctr) < target, tmo_bar);
        __builtin_amdgcn_fence(__ATOMIC_ACQUIRE, "agent");
        asm volatile("s_waitcnt vmcnt(0)" ::: "memory");
    }
    __syncthreads();
}
struct Args { const float* in[20]; float* out; unsigned char* ws; int ph_lo, ph_hi; unsigned rep_mask, pad; };
struct Frame {
    LAS unsigned char* lds; int tid, lane, wave, G, vcu, bid;
    unsigned char* ws; float* out;
    const float *x_prompt, *x_sample, *state_hgrn, *cache_k, *cache_v, *state_ret, *state_conv, *norm1, *w_in, *lbraw, *hgrn_g, *sinks, *ret_g, *w_out, *norm2, *w_up, *conv_w, *conv_b, *w_down, *fin_g;
};

struct P0Item { const float* W; bf16* WT; const float* gain; int K, N, k0, n0, r0; };
__device__ __forceinline__ void p0_item_load(const P0Item& it, f32x4 (&v)[16], float (&g)[16], int lane) {
    const int c4 = (lane & 15) * 4, kr = lane >> 4;
#pragma unroll
    for (int i = 0; i < 16; ++i) v[i] = *(const f32x4*)(it.W + (size_t)(it.k0 + 4 * i + kr) * it.N + it.n0 + c4);
    if (it.gain) {
#pragma unroll
        for (int i = 0; i < 16; ++i) g[i] = it.gain[it.k0 + 4 * i + kr]; }
    else {
#pragma unroll
        for (int i = 0; i < 16; ++i) g[i] = 1.0f; }
}
__device__ __forceinline__ void p0_item_emit(const P0Item& it, const f32x4 (&v)[16], const float (&gg)[16], LAS float* scr, int lane) {
    const int c4 = (lane & 15) * 4, kr = lane >> 4;
#pragma unroll
    for (int i = 0; i < 16; ++i) { const int kk = 4 * i + kr; const float g = gg[i]; LAS float* d = scr + kk * 65 + c4; d[0] = v[i][0] * g; d[1] = v[i][1] * g; d[2] = v[i][2] * g; d[3] = v[i][3] * g; }
    LDS_WAIT(); asm volatile("" ::: "memory");
    const int c = lane & 7;
#pragma unroll
    for (int j = 0; j < 8; ++j) { const int n = (lane >> 3) + 8 * j; const LAS float* s = scr + (8 * c) * 65 + n;
        u32x4 o; o.x = pk2(s[0 * 65], s[1 * 65]); o.y = pk2(s[2 * 65], s[3 * 65]); o.z = pk2(s[4 * 65], s[5 * 65]); o.w = pk2(s[6 * 65], s[7 * 65]);
        *(u32x4*)(it.WT + (size_t)(it.r0 + n) * it.K + it.k0 + 8 * c) = o; }
    LDS_WAIT(); asm volatile("" ::: "memory");
}
__device__ __forceinline__ float row_to_bf16(const float* xrow, bf16* orow, float* copy, int lane) {
    const f32x4* xr = (const f32x4*)xrow + lane; f32x4 v[8]; float s = 0.f;
#pragma unroll
    for (int j = 0; j < 8; ++j) { v[j] = xr[64 * j]; s += (v[j][0] * v[j][0] + v[j][1] * v[j][1]) + (v[j][2] * v[j][2] + v[j][3] * v[j][3]); }
    u32x2* o8 = (u32x2*)orow + lane;
#pragma unroll
    for (int j = 0; j < 8; ++j) { u32x2 w; w.x = pk2(v[j][0], v[j][1]); w.y = pk2(v[j][2], v[j][3]); o8[64 * j] = w; if (copy) ((f32x4*)copy + lane)[64 * j] = v[j]; }
    return wave_sum(s);
}
__device__ __forceinline__ void p0_prologue(Frame& F) {
    LAS float* scr = (LAS float*)(F.lds + F.wave * 17408);
    const int gw = F.vcu * NWAVES + F.wave, NGW = F.G * NWAVES;
    constexpr int I_IN = (DM / 64) * (NCOL / 64), I_OUT = (DM / 64) * (DM / 64), I_UP = (DM / 64) * (NUP / 64), I_DN = (DFF / 64) * (DM / 64), I_L = I_IN + I_OUT + I_UP + I_DN;
    auto describe = [&](int itx, P0Item& d) { const int l = itx / I_L; int r = itx % I_L; bool perm = false;
        if (r < I_IN) { d.W = F.w_in + (size_t)l * DM * NCOL; d.WT = (bf16*)(F.ws + WS_WIN + l * SZ_WIN); d.gain = F.norm1 + l * DM; d.K = DM; d.N = NCOL; }
        else if ((r -= I_IN) < I_OUT) { d.W = F.w_out + (size_t)l * DM * DM; d.WT = (bf16*)(F.ws + WS_WOUT + l * SZ_WOUT); d.gain = nullptr; d.K = DM; d.N = DM; }
        else if ((r -= I_OUT) < I_UP) { d.W = F.w_up + (size_t)l * DM * NUP; d.WT = (bf16*)(F.ws + WS_WUP + l * SZ_WUP); d.gain = F.norm2 + l * DM; d.K = DM; d.N = NUP; perm = true; }
        else { r -= I_UP; d.W = F.w_down + (size_t)l * DFF * DM; d.WT = (bf16*)(F.ws + WS_WDN + l * SZ_WDN); d.gain = nullptr; d.K = DFF; d.N = DM; }
        const int nblk = d.N / 64, kb = r / nblk, nb = r % nblk; d.k0 = 64 * kb; d.n0 = 64 * nb; d.r0 = d.n0;
        if (perm) { const int half = d.n0 >= DFF ? 1 : 0, np = d.n0 - half * DFF; d.r0 = 256 * (np >> 7) + 128 * half + (np & 127); } };
    { P0Item ia, ib; f32x4 va[16], vb[16]; float ga[16], gb[16]; int it = gw; constexpr int N_IT = DEPTH * I_L;
      if (it < N_IT) { describe(it, ia); p0_item_load(ia, va, ga, F.lane); __builtin_amdgcn_sched_barrier(0); }
      while (it < N_IT) { int itn = it + NGW;
          if (itn < N_IT) { describe(itn, ib); p0_item_load(ib, vb, gb, F.lane); __builtin_amdgcn_sched_barrier(0); }
          p0_item_emit(ia, va, ga, scr, F.lane);
          it = itn; if (it >= N_IT) break;
          itn = it + NGW;
          if (itn < N_IT) { describe(itn, ia); p0_item_load(ia, va, ga, F.lane); __builtin_amdgcn_sched_barrier(0); }
          p0_item_emit(ib, vb, gb, scr, F.lane);
          it = itn; } }
    float* SS = (float*)(F.ws + WS_SS);
    { f32x4 va[8], vb[8]; int m = gw;
      auto rowptr = [&](int mm) { return mm < MP ? F.x_prompt + (size_t)mm * DM : F.x_sample + (size_t)(mm - MP) * DM; };
      if (m < MP + DB) { const f32x4* xr = (const f32x4*)rowptr(m) + F.lane;
#pragma unroll
          for (int j = 0; j < 8; ++j) va[j] = xr[64 * j]; }
      while (m < MP + DB) { const int mn = m + NGW; const bool more = mn < MP + DB;
          if (more) { const f32x4* xr = (const f32x4*)rowptr(mn) + F.lane;
#pragma unroll
              for (int j = 0; j < 8; ++j) vb[j] = xr[64 * j]; }
          float s = 0.f;
#pragma unroll
          for (int j = 0; j < 8; ++j) s += (va[j][0] * va[j][0] + va[j][1] * va[j][1]) + (va[j][2] * va[j][2] + va[j][3] * va[j][3]);
          bf16* orow = m < MP ? (bf16*)(F.ws + WS_XB) + (size_t)m * DM : (bf16*)(F.ws + WS_XSB) + (size_t)(m - MP) * DM;
          u32x2* o8 = (u32x2*)orow + F.lane;
#pragma unroll
          for (int j = 0; j < 8; ++j) { u32x2 w; w.x = pk2(va[j][0], va[j][1]); w.y = pk2(va[j][2], va[j][3]); o8[64 * j] = w; if (m >= MP) ((f32x4*)((float*)(F.ws + WS_XS) + (size_t)(m - MP) * DM) + F.lane)[64 * j] = va[j]; }
          s = wave_sum(s);
          if (m < MP && F.lane < 8) SS[(size_t)m * 8 + F.lane] = F.lane == 0 ? s : 0.f;
          if (more) {
#pragma unroll
              for (int j = 0; j < 8; ++j) va[j] = vb[j]; }
          m = mn; } }
}

template <class Epi> __device__ __forceinline__ void small_gemm_unit(Frame& F, LAS float* red, const bf16* A, const bf16* Bt, int K, int n0, const Epi& E, int q0 = 0, int qs = 1) {
    const int lane = F.lane, r = lane & 15, g = lane >> 4, kw = K / 8, kbeg = F.wave * 64;
    const bf16* ap = A + (size_t)r * K + kbeg + 8 * g; const bf16* bp = Bt + (size_t)(n0 + r) * K + kbeg + 8 * g; const size_t half = (size_t)16 * K;
    f32x4 acc[2][2];
#pragma unroll
    for (int i = 0; i < 4; ++i) acc[i >> 1][i & 1] = (f32x4){0.f, 0.f, 0.f, 0.f};
    bf16x8 qa[4][2][2], qb[4][2][2]; const int nq = (kw / 64 - q0 + qs - 1) / qs;
#define SG_LOAD(s, q) do { _Pragma("unroll") for (int j = 0; j < 2; ++j) _Pragma("unroll") for (int e = 0; e < 2; ++e) { const int qe_ = q0 + (q) * qs; qa[s][j][e] = *(const bf16x8*)(ap + e * half + qe_ * 512 + 32 * j); qb[s][j][e] = *(const bf16x8*)(bp + e * half + qe_ * 512 + 32 * j); } \
        __builtin_amdgcn_sched_barrier(0); } while (0)
#define SG_MMA(s) do { _Pragma("unroll") for (int j = 0; j < 2; ++j) _Pragma("unroll") for (int e = 0; e < 2; ++e) _Pragma("unroll") for (int f = 0; f < 2; ++f) acc[e][f] = MFMA16(qa[s][j][e], qb[s][j][f], acc[e][f]); } while (0)
#pragma unroll
    for (int s_ = 0; s_ < 4; ++s_) if (s_ < nq) SG_LOAD(s_, s_);
#pragma unroll 1
    for (int q = 0; q < nq; q += 4) {
#pragma unroll
        for (int s_ = 0; s_ < 4; ++s_) if (q + s_ < nq) { SG_MMA(s_); if (q + s_ + 4 < nq) SG_LOAD(s_, q + s_ + 4); }
    }
#undef SG_LOAD
#undef SG_MMA
#pragma unroll
    for (int e = 0; e < 2; ++e)
#pragma unroll
        for (int f = 0; f < 2; ++f)
#pragma unroll
            for (int t = 0; t < 4; ++t) red[(F.wave * 32 + 16 * e + 4 * g + t) * 32 + 16 * f + r] = acc[e][f][t];
    LDS_WAIT(); __syncthreads();
    { const int row = F.tid >> 4, c2 = (F.tid & 15) * 2; float v0 = 0.f, v1 = 0.f;
#pragma unroll
      for (int w = 0; w < 8; ++w) { const f32x2 t = *(const LAS f32x2*)(red + (w * 32 + row) * 32 + c2); v0 += t.x; v1 += t.y; }
      E(row, n0 + c2, v0, v1); }
    LDS_WAIT(); __syncthreads();
}
__device__ __forceinline__ void sample_rstd(Frame& F, LAS float* rs) {
    const float* XS = (const float*)(F.ws + WS_XS);
    for (int i = 0; i < 4; ++i) { const int row = F.wave * 4 + i; const f32x4* xr = (const f32x4*)(XS + (size_t)row * DM) + F.lane; float s = 0.f; f32x4 v[8];
#pragma unroll
        for (int j = 0; j < 8; ++j) v[j] = xr[64 * j];
        asm volatile("" ::: "memory");
#pragma unroll
        for (int j = 0; j < 8; ++j) s += (v[j][0] * v[j][0] + v[j][1] * v[j][1]) + (v[j][2] * v[j][2] + v[j][3] * v[j][3]);
        s = wave_sum(s); if (F.lane == 0) rs[row] = 1.0f / sqrtf(s * (1.0f / DM) + EPS); }
    LDS_WAIT(); __syncthreads();
}
struct EpiS_scale { float* O; int ldo; const LAS float* rs; __device__ __forceinline__ void operator()(int row, int col, float v0, float v1) const { const float r = rs[row]; *(f32x2*)(O + (size_t)row * ldo + col) = (f32x2){v0 * r, v1 * r}; } };
struct EpiS_res { float* XS; bf16* XSB; __device__ __forceinline__ void operator()(int row, int col, float v0, float v1) const { float* p = XS + (size_t)row * DM + col; const f32x2 o = *(f32x2*)p; const float a = o.x + v0, b = o.y + v1; *(f32x2*)p = (f32x2){a, b}; *(unsigned*)(XSB + (size_t)row * DM + col) = pk2(a, b); } };
struct EpiS_part { float* P; __device__ __forceinline__ void operator()(int row, int col, float v0, float v1) const { *(f32x2*)(P + (size_t)row * DM + col) = (f32x2){v0, v1}; } };
constexpr size_t WS_PART = WS_END;
__device__ __forceinline__ void sample_kpart(Frame& F, int which, int layer, unsigned* ctr) {
    if (F.G != 256) return;
    const int u = F.bid & 63, ks = F.bid >> 6; EpiS_part E{(float*)(F.ws + WS_PART) + (size_t)ks * DB * DM};
    if (which == 2) small_gemm_unit(F, (LAS float*)F.lds, (const bf16*)(F.ws + WS_MIXS), (const bf16*)(F.ws + WS_WOUT + layer * SZ_WOUT), DM, 32 * u, E, ks, 4);
    else small_gemm_unit(F, (LAS float*)F.lds, (const bf16*)(F.ws + WS_HFS), (const bf16*)(F.ws + WS_WDN + layer * SZ_WDN), DFF, 32 * u, E, ks, 4);
    asm volatile("s_waitcnt vmcnt(0)" ::: "memory"); __syncthreads();
    if (threadIdx.x == 0) { __builtin_amdgcn_fence(__ATOMIC_RELEASE, "agent"); asm volatile("s_waitcnt vmcnt(0)" ::: "memory"); (void)xb_add(ctr, 1u); }
}
__device__ __forceinline__ void sample_kreduce(Frame& F, unsigned* ctr, unsigned* tmo_bar) {
    if (F.G != 256 || F.bid >= 64) return;
    if (threadIdx.x == 0) { XB_SPIN(xb_ld(ctr) < 256u, tmo_bar); __builtin_amdgcn_fence(__ATOMIC_ACQUIRE, "agent"); asm volatile("s_waitcnt vmcnt(0)" ::: "memory"); }
    __syncthreads();
    const int row = F.tid >> 4, col = 32 * F.bid + (F.tid & 15) * 2; const float* P = (const float*)(F.ws + WS_PART) + (size_t)row * DM + col;
    const f32x2 p0 = *(const f32x2*)P, p1 = *(const f32x2*)(P + (size_t)DB * DM), p2 = *(const f32x2*)(P + (size_t)2 * DB * DM), p3 = *(const f32x2*)(P + (size_t)3 * DB * DM);
    EpiS_res{(float*)(F.ws + WS_XS), (bf16*)(F.ws + WS_XSB)}(row, col, (p0.x + p1.x) + (p2.x + p3.x), (p0.y + p1.y) + (p2.y + p3.y));
}
__device__ __forceinline__ void sample_gemm_phase(Frame& F, int which, int layer, int wg_rank, int wg_count) {
    if (wg_rank < 0 || wg_rank >= wg_count) return;
    LAS float* red = (LAS float*)F.lds; LAS float* rs = (LAS float*)(F.lds + 32768);
    const int N = which == 1 ? NCOL : which == 3 ? NUP : DM;
    if (wg_rank >= N / 32) return;
    if (which == 1 || which == 3) sample_rstd(F, rs);
    for (int u = wg_rank; u < N / 32; u += wg_count) {
        if (which == 1) small_gemm_unit(F, red, (const bf16*)(F.ws + WS_XSB), (const bf16*)(F.ws + WS_WIN + layer * SZ_WIN), DM, 32 * u, EpiS_scale{(float*)(F.ws + WS_ZS), NCOL, rs});
        else if (which == 2) small_gemm_unit(F, red, (const bf16*)(F.ws + WS_MIXS), (const bf16*)(F.ws + WS_WOUT + layer * SZ_WOUT), DM, 32 * u, EpiS_res{(float*)(F.ws + WS_XS), (bf16*)(F.ws + WS_XSB)});
        else if (which == 3) small_gemm_unit(F, red, (const bf16*)(F.ws + WS_XSB), (const bf16*)(F.ws + WS_WUP + layer * SZ_WUP), DM, 32 * u, EpiS_scale{(float*)(F.ws + WS_US), NUP, rs});
        else small_gemm_unit(F, red, (const bf16*)(F.ws + WS_HFS), (const bf16*)(F.ws + WS_WDN + layer * SZ_WDN), DFF, 32 * u, EpiS_res{(float*)(F.ws + WS_XS), (bf16*)(F.ws + WS_XSB)});
    }
}

__device__ __forceinline__ unsigned opaque(unsigned x) { asm volatile("" : "+v"(x)); return x; }
struct ImgAddr { unsigned RB, TB0, TB1, TP; };
__device__ __forceinline__ ImgAddr make_img_addr(unsigned lane) { const unsigned g = lane >> 4; ImgAddr a; a.RB = off_b(lane & 15, g); a.TB0 = tr_addr(lane, 8 * g, 0); a.TB1 = tr_addr(lane, 8 * g + 4, 0); a.TP = tr_addr(lane, 4 * g, 0); return a; }
#define FRAG_ROW(img, A, rb, s) lds_frag(lds + (img) + 4096 * (rb), (A).RB ^ ((s) << 6))
#define FRAG_TRN(img, A, ks, c) cat8(tr_read(lds + (img) + 8192 * (ks), (A).TB0 ^ ((c) << 5)), tr_read(lds + (img) + 8192 * (ks), (A).TB1 ^ ((c) << 5)))
#define FRAG_TRP(img, A, k0, k1, c) cat8(tr_read(lds + (img) + 4096 * (k0), (A).TP ^ ((c) << 5)), tr_read(lds + (img) + 4096 * (k1), (A).TP ^ ((c) << 5)))
constexpr size_t WS_USTATE = WS_U, WS_SFRAG = WS_U + 64 * MiB, WS_DEC = WS_U + 96 * MiB;
static_assert(WS_DEC + 1024 * 512 <= WS_U + (size_t)MP * NUP * 2, "scan scratch overlays the (dead) up-projection buffer");
constexpr int CH_QH = 0, CH_KL = 16384, CH_V = 32768, CH_O = 49152, CH_G = 81920, CH_TOT = 98304, CH_STAT = 106496;
struct ChainRaw { u32x2 q[4], k[4], v[4], g[4]; f32x4 lf[4]; };
template <bool FULL> __device__ __forceinline__ void chain_load(ChainRaw& r, const bf16* Z, const float* LOGF, int unit, int tq, int dg) {
    const int chain = unit >> 5, c = unit & 31, grp = chain >> 4, b = (chain & 15) >> 2, h = chain & 3;
    const int cq = (grp ? C_QC : C_QA) + h * 128, ck = (grp ? C_KC : C_FA) + h * 128, cv = (grp ? C_VC : C_IA) + h * 128, cg = (grp ? C_GC : C_GA) + h * 128;
    const size_t R0 = (size_t)b * SEQ + 64 * c + 4 * tq;
#pragma unroll
    for (int i = 0; i < 4; ++i) { const bf16* zr = Z + (R0 + i) * NCOL + 4 * dg; r.k[i] = *(const u32x2*)(zr + ck); r.v[i] = *(const u32x2*)(zr + cv);
        if (FULL) { r.q[i] = *(const u32x2*)(zr + cq); r.g[i] = *(const u32x2*)(zr + cg); }
        if (grp == 0) r.lf[i] = *(const f32x4*)(LOGF + (R0 + i) * 512 + h * 128 + 4 * dg); else r.lf[i] = (f32x4){0.f, 0.f, 0.f, 0.f}; }
}
__device__ __forceinline__ void chain_prefix(LAS unsigned char* lds, const ChainRaw& raw, int grp, int h, int tq, unsigned bTOT, f32x4 (&bb)[4], f32x4& bl) {
    if (grp == 0) {
        f32x4 p[4]; p[0] = raw.lf[0]; p[1] = p[0] + raw.lf[1]; p[2] = p[1] + raw.lf[2]; p[3] = p[2] + raw.lf[3];
        *(LAS f32x4*)(lds + bTOT + tq * 512) = p[3];
        WG_BAR();
        f32x4 before = (f32x4){0.f, 0.f, 0.f, 0.f}, total = (f32x4){0.f, 0.f, 0.f, 0.f};
#pragma unroll 4
        for (int q = 0; q < 16; ++q) { const f32x4 t4 = *(const LAS f32x4*)(lds + bTOT + q * 512); total += t4; if (q < tq) before += t4; }
#pragma unroll
        for (int i = 0; i < 4; ++i) bb[i] = (before + p[i]) * LOG2E;
        bl = total * LOG2E;
    } else {
        WG_BAR();
        const float lg2 = log2f(1.0f - exp2f(-5.0f - (float)h));
#pragma unroll
        for (int i = 0; i < 4; ++i) { const float v = (float)(4 * tq + i + 1) * lg2; bb[i] = (f32x4){v, v, v, v}; }
        const float v = 64.0f * lg2; bl = (f32x4){v, v, v, v};
    }
}
__device__ __forceinline__ void chainA_units(Frame& F, int first, int count) {
    const int lane0 = F.lane, w = F.wave;
    LAS unsigned char* lds = F.lds;
    const bf16* Z = (const bf16*)(F.ws + WS_Z); const float* LOGF = (const float*)(F.ws + WS_LOGF);
    ChainRaw raw, rawn;
    { const int lane = (int)opaque((unsigned)lane0); chain_load<false>(raw, Z, LOGF, first, (w << 1) | (lane >> 5), lane & 31); }
    for (int ui = 0; ui < count; ++ui) {
        const int unit = first + ui, chain = unit >> 5, grp = chain >> 4, h = chain & 3;
        const int lane = (int)opaque((unsigned)lane0), tq = (w << 1) | (lane >> 5), dg = lane & 31;
        if (ui + 1 < count) chain_load<false>(rawn, Z, LOGF, unit + 1, tq, dg);
        const ImgAddr IA = make_img_addr(lane);
        const unsigned WA = 1024u * tq + 16u * ((dg >> 1) ^ (tq & 3)) + 8u * (dg & 1);
        const unsigned bTOT = opaque(CH_TOT + 16 * dg);
        f32x4 bl, bb[4];
        chain_prefix(lds, raw, grp, h, tq, bTOT, bb, bl);
        if (tq == 0) { f32x4 d; for (int j = 0; j < 4; ++j) d[j] = fexp2(fmaxf(bl[j], -125.0f)); *(f32x4*)((float*)(F.ws + WS_DEC) + (size_t)unit * 128 + 4 * dg) = d; }
        const float ksc = grp ? 0.08838834764831845f : 1.0f;
#pragma unroll
        for (int i = 0; i < 4; ++i) { const unsigned o8 = (WA ^ (i << 6)) + 256 * i; f32x4 ek;
#pragma unroll
            for (int j = 0; j < 4; ++j) ek[j] = fexp2(fmaxf(bl[j] - bb[i][j], -125.0f)) * ksc;
            u32x2 kl; kl.x = pk2(bflo(raw.k[i].x) * ek[0], bfhi(raw.k[i].x) * ek[1]); kl.y = pk2(bflo(raw.k[i].y) * ek[2], bfhi(raw.k[i].y) * ek[3]);
            *(LAS u32x2*)(lds + CH_KL + o8) = kl; *(LAS u32x2*)(lds + CH_V + o8) = raw.v[i]; }
        WG_BAR();
        f32x4 sacc[8];
#pragma unroll
        for (int n = 0; n < 8; ++n) sacc[n] = (f32x4){0.f, 0.f, 0.f, 0.f};
        { const unsigned wx = (unsigned)w << 5;
#pragma unroll
            for (int ks = 0; ks < 2; ++ks) { const bf16x8 af = cat8(tr_read(lds + CH_KL + 8192 * ks, IA.TB0 ^ wx), tr_read(lds + CH_KL + 8192 * ks, IA.TB1 ^ wx));
#pragma unroll
                for (int n = 0; n < 8; ++n) sacc[n] = MFMA16(af, FRAG_TRN(CH_V, IA, ks, n), sacc[n]); } }
        u32x2* up = (u32x2*)(F.ws + WS_USTATE) + ((size_t)(unit * 8 + w) * 8) * 64 + lane;
#pragma unroll
        for (int n = 0; n < 8; ++n) { u32x2 wv; wv.x = pk2(sacc[n][0], sacc[n][1]); wv.y = pk2(sacc[n][2], sacc[n][3]); up[n * 64] = wv; }
        WG_BAR();
        raw = rawn;
    }
}
__device__ __forceinline__ void chain_scan(Frame& F, int layer) {
    if (F.wave >= 4) return;
    const int tidx = F.vcu * 256 + F.tid; if (tidx >= 65536) return;
    const int chain = tidx >> 11, p = (tidx >> 9) & 3, n = (tidx >> 6) & 7, lane = tidx & 63, g = lane >> 4, l15 = lane & 15;
    const float* DEC = (const float*)(F.ws + WS_DEC); const u32x2* US = (const u32x2*)(F.ws + WS_USTATE); u32x4* SF = (u32x4*)(F.ws + WS_SFRAG);
    f32x4 S0 = (f32x4){0.f, 0.f, 0.f, 0.f}, S1 = S0;
    f32x4 Da[4], Db[4], nDa[4], nDb[4]; u32x2 Ua[4], Ub[4], nUa[4], nUb[4];
#define SCAN_LOAD(DA, DB, UA, UB, c0) do { _Pragma("unroll") for (int k = 0; k < 4; ++k) { const int unit = chain * 32 + (c0) + k; \
        DA[k] = *(const f32x4*)(DEC + (size_t)unit * 128 + 32 * p + 4 * g); DB[k] = *(const f32x4*)(DEC + (size_t)unit * 128 + 32 * p + 16 + 4 * g); \
        UA[k] = US[((size_t)(unit * 8 + 2 * p) * 8 + n) * 64 + lane]; UB[k] = US[((size_t)(unit * 8 + 2 * p + 1) * 8 + n) * 64 + lane]; } } while (0)
    SCAN_LOAD(Da, Db, Ua, Ub, 0);
#pragma unroll 1
    for (int cb = 0; cb < 32; cb += 4) {
        if (cb + 4 < 32) SCAN_LOAD(nDa, nDb, nUa, nUb, cb + 4);
#pragma unroll
        for (int k = 0; k < 4; ++k) { const int unit = chain * 32 + cb + k;
            const f32x4 d0 = Da[k] * S0, d1 = Db[k] * S1;
            u32x4 wv; wv.x = pk2(d0[0], d0[1]); wv.y = pk2(d0[2], d0[3]); wv.z = pk2(d1[0], d1[1]); wv.w = pk2(d1[2], d1[3]);
            SF[((size_t)(unit * 4 + p) * 8 + n) * 64 + lane] = wv;
            S0 = d0 + (f32x4){bflo(Ua[k].x), bfhi(Ua[k].x), bflo(Ua[k].y), bfhi(Ua[k].y)}; S1 = d1 + (f32x4){bflo(Ub[k].x), bfhi(Ub[k].x), bflo(Ub[k].y), bfhi(Ub[k].y)}; }
#pragma unroll
        for (int k = 0; k < 4; ++k) { Da[k] = nDa[k]; Db[k] = nDb[k]; Ua[k] = nUa[k]; Ub[k] = nUb[k]; }
    }
#undef SCAN_LOAD
    const int grp = chain >> 4, bh = chain & 15;
    float* So = F.out + (grp ? O_PRET : O_PHGRN) + ((size_t)layer * BATCH * 4 + bh) * 16384;
#pragma unroll
    for (int j = 0; j < 4; ++j) { So[(32 * p + 4 * g + j) * 128 + 16 * n + l15] = S0[j]; So[(32 * p + 16 + 4 * g + j) * 128 + 16 * n + l15] = S1[j]; }
}
__device__ __forceinline__ void chainC_units(Frame& F, int layer, int first, int count) {
    const int lane0 = F.lane, w = F.wave, tb = w & 3, nh = w >> 2;
    LAS unsigned char* lds = F.lds;
    const bf16* Z = (const bf16*)(F.ws + WS_Z); const float* LOGF = (const float*)(F.ws + WS_LOGF); bf16* MIX = (bf16*)(F.ws + WS_MIX);
    ChainRaw raw; bf16x8 sf[4][4], sfn[4][4]; f32x4 gn4;
    { const int lane = (int)opaque((unsigned)lane0); chain_load<true>(raw, Z, LOGF, first, (w << 1) | (lane >> 5), lane & 31);
      const bf16x8* sp = (const bf16x8*)(F.ws + WS_SFRAG) + ((size_t)first * 4 * 8 + 4 * nh) * 64 + lane;
#pragma unroll
      for (int p = 0; p < 4; ++p)
#pragma unroll
          for (int i = 0; i < 4; ++i) sf[p][i] = sp[(p * 8 + i) * 64];
      const int chain0 = first >> 5; gn4 = *(const f32x4*)(((chain0 >> 4) ? F.ret_g : F.hgrn_g) + layer * 512 + (chain0 & 3) * 128 + 4 * (lane & 31)); }
    for (int ui = 0; ui < count; ++ui) {
        const int unit = first + ui, chain = unit >> 5, c = unit & 31, grp = chain >> 4, b = (chain & 15) >> 2, h = chain & 3;
        const int lane = (int)opaque((unsigned)lane0), g = lane >> 4, l15 = lane & 15, tq = (w << 1) | (lane >> 5), dg = lane & 31;
        if (ui + 1 < count) { const bf16x8* sp = (const bf16x8*)(F.ws + WS_SFRAG) + ((size_t)(unit + 1) * 4 * 8 + 4 * nh) * 64 + lane;
#pragma unroll
            for (int p = 0; p < 4; ++p)
#pragma unroll
                for (int i = 0; i < 4; ++i) sfn[p][i] = sp[(p * 8 + i) * 64]; }
        const ImgAddr IA = make_img_addr(lane);
        const unsigned WA = 1024u * tq + 16u * ((dg >> 1) ^ (tq & 3)) + 8u * (dg & 1);
        const unsigned QP = 256u * l15 + 16u * ((g >> 1) ^ (((l15 & 3) << 2) | ((l15 >> 2) & 3))) + 8u * (g & 1);
        const unsigned bO = opaque(CH_O + ((16 * tb + 4 * g) * 128 + 64 * nh + l15) * 4), bOr = opaque(CH_O + (4 * tq * 128 + 4 * dg) * 4);
        const unsigned bTOT = opaque(CH_TOT + 16 * dg), bSTAT = opaque(CH_STAT), bG = opaque(CH_G + (4 * tq * 128 + 4 * dg) * 2);
        f32x4 bl, bb[4];
        chain_prefix(lds, raw, grp, h, tq, bTOT, bb, bl);
#ifdef CC_REP_P
        WG_BAR(); chain_prefix(lds, raw, grp, h, tq, bTOT, bb, bl);
#endif
#ifdef CC_REP_A
        for (int rep_ = 0; rep_ < 2; ++rep_) { asm volatile("" ::: "memory");
#endif
        const float ksc = grp ? 0.08838834764831845f : 1.0f;
        {
#pragma unroll
        for (int i = 0; i < 4; ++i) { const unsigned o8 = (WA ^ (i << 6)) + 256 * i;
            f32x4 eq, ek;
#pragma unroll
            for (int j = 0; j < 4; ++j) { eq[j] = fexp2(fminf(bb[i][j] - bl[j], 115.0f)); ek[j] = fexp2(fmaxf(bl[j] - bb[i][j], -125.0f)) * ksc; }
            u32x2 qh, kl, gg; qh.x = pk2(bflo(raw.q[i].x) * eq[0], bfhi(raw.q[i].x) * eq[1]); qh.y = pk2(bflo(raw.q[i].y) * eq[2], bfhi(raw.q[i].y) * eq[3]);
            kl.x = pk2(bflo(raw.k[i].x) * ek[0], bfhi(raw.k[i].x) * ek[1]); kl.y = pk2(bflo(raw.k[i].y) * ek[2], bfhi(raw.k[i].y) * ek[3]);
            gg.x = pk2(gn4[0] * silu(bflo(raw.g[i].x)), gn4[1] * silu(bfhi(raw.g[i].x))); gg.y = pk2(gn4[2] * silu(bflo(raw.g[i].y)), gn4[3] * silu(bfhi(raw.g[i].y)));
            *(LAS u32x2*)(lds + CH_QH + o8) = qh; *(LAS u32x2*)(lds + CH_KL + o8) = kl; *(LAS u32x2*)(lds + CH_V + o8) = raw.v[i]; *(LAS u32x2*)(lds + bG + i * 256) = gg; } }
#ifdef CC_REP_A
        }
#endif
        WG_BAR();
        if (ui + 1 < count) chain_load<true>(raw, Z, LOGF, unit + 1, tq, dg);
#ifdef CC_REP_M
        for (int rep_ = 0; rep_ < 2; ++rep_) { asm volatile("" ::: "memory");
#endif
        f32x4 att[4];
        { bf16x8 qf[4]; const unsigned qoff = 4096u * tb;
#pragma unroll
            for (int ks = 0; ks < 4; ++ks) qf[ks] = lds_frag(lds + CH_QH, qoff + (IA.RB ^ (ks << 6)));
#pragma unroll
            for (int sb = 0; sb < 4; ++sb) { att[sb] = (f32x4){0.f, 0.f, 0.f, 0.f};
#pragma unroll
                for (int ks = 0; ks < 4; ++ks) att[sb] = MFMA16(FRAG_ROW(CH_KL, IA, sb, ks), qf[ks], att[sb]);
#pragma unroll
                for (int j = 0; j < 4; ++j) att[sb][j] = (16 * sb + 4 * g + j <= 16 * tb + l15) ? att[sb][j] : 0.f; } }
        { const bf16x8 pf0 = pack8(att[0], att[1]), pf1 = pack8(att[2], att[3]);
            bf16x8 qp[4];
#pragma unroll
            for (int p = 0; p < 4; ++p) { const s16x4 lo = *(const LAS s16x4*)(lds + CH_QH + 4096 * tb + (QP ^ ((4 * p) << 4))), hi = *(const LAS s16x4*)(lds + CH_QH + 4096 * tb + (QP ^ ((4 * p + 2) << 4))); qp[p] = cat8(lo, hi); }
            f32x4 oc[4];
#pragma unroll
            for (int i = 0; i < 4; ++i) { const unsigned nx = (unsigned)(4 * nh + i) << 5; f32x4 a = (f32x4){0.f, 0.f, 0.f, 0.f};
                a = MFMA16(pf0, cat8(tr_read(lds + CH_V, IA.TP ^ nx), tr_read(lds + CH_V + 4096, IA.TP ^ nx)), a);
                a = MFMA16(pf1, cat8(tr_read(lds + CH_V + 8192, IA.TP ^ nx), tr_read(lds + CH_V + 12288, IA.TP ^ nx)), a);
#pragma unroll
                for (int p = 0; p < 4; ++p) a = MFMA16(qp[p], sf[p][i], a);
                oc[i] = a; }
#pragma unroll
            for (int j = 0; j < 4; ++j) { float s = (oc[0][j] + oc[1][j]) + (oc[2][j] + oc[3][j]), q = (oc[0][j] * oc[0][j] + oc[1][j] * oc[1][j]) + (oc[2][j] * oc[2][j] + oc[3][j] * oc[3][j]);
                s += __shfl_xor(s, 1); q += __shfl_xor(q, 1); s += __shfl_xor(s, 2); q += __shfl_xor(q, 2); s += __shfl_xor(s, 4); q += __shfl_xor(q, 4); s += __shfl_xor(s, 8); q += __shfl_xor(q, 8);
                const int t = 16 * tb + 4 * g + j;
                if (l15 == 0) *(LAS f32x2*)(lds + bSTAT + t * 16 + nh * 8) = (f32x2){s, q};
#pragma unroll
                for (int i = 0; i < 4; ++i) *(LAS float*)(lds + bO + j * 512 + i * 64) = oc[i][j]; } }
#ifdef CC_REP_M
        }
#endif
        WG_BAR();
#ifdef CC_REP_F
        for (int rep_ = 0; rep_ < 2; ++rep_)
#endif
        { const size_t Rp = (size_t)b * SEQ + 64 * c + 4 * tq; const int mixoff = (grp ? 1536 : 0) + h * 128;
#pragma unroll
            for (int i = 0; i < 4; ++i) { const int t = 4 * tq + i; const f32x4 o = *(const LAS f32x4*)(lds + bOr + i * 512); const f32x4 sp = *(const LAS f32x4*)(lds + bSTAT + t * 16); const u32x2 gv = *(const LAS u32x2*)(lds + bG + i * 256);
                const float mean = grp ? (sp[0] + sp[2]) * (1.0f / 128.0f) : 0.f; const float var = (sp[1] + sp[3]) * (1.0f / 128.0f) - mean * mean; const float rs = __builtin_amdgcn_rsqf(fmaxf(var, 0.f) + EPS);
                u32x2 wv; wv.x = pk2((o[0] - mean) * rs * bflo(gv.x), (o[1] - mean) * rs * bfhi(gv.x)); wv.y = pk2((o[2] - mean) * rs * bflo(gv.y), (o[3] - mean) * rs * bfhi(gv.y));
                *(u32x2*)(MIX + (Rp + i) * DM + mixoff + 4 * dg) = wv; } }
#pragma unroll
        for (int p = 0; p < 4; ++p)
#pragma unroll
            for (int i = 0; i < 4; ++i) sf[p][i] = sfn[p][i];
    }
    WG_BAR();
}

constexpr int SW_K = 0, SW_V = 65536;
__device__ __forceinline__ void swa_prompt_unit(Frame& F, int layer, int unit) {
    const int tid = F.tid, lane = F.lane, w = F.wave, g = lane >> 4, l15 = lane & 15;
    LAS unsigned char* lds = F.lds;
    const bf16* Z = (const bf16*)(F.ws + WS_Z); bf16* MIX = (bf16*)(F.ws + WS_MIX);
    const int hp = unit & 1, kvh = (unit >> 1) & 1, n = (unit >> 2) & 15, b = unit >> 6;
#pragma unroll
    for (int it_ = 0; it_ < 8; ++it_) { const int idx = tid + it_ * NTHR; const int row = idx >> 4, ch = idx & 15; u32x4 kx = (u32x4){0u, 0u, 0u, 0u}, vx = kx;
        if (n > 0 || row >= 128) { const bf16* zr = Z + ((size_t)b * SEQ + 128 * (n - 1) + row) * NCOL; kx = *(const u32x4*)(zr + C_KB + kvh * 128 + ch * 8); vx = *(const u32x4*)(zr + C_VB + kvh * 128 + ch * 8); }
        *(LAS u32x4*)(lds + SW_K + off_b(row, ch)) = kx; *(LAS u32x4*)(lds + SW_V + off_b(row, ch)) = vx; }
    bf16x8 qall[2][4];
    { const int r_ = 16 * w + l15;
#pragma unroll
      for (int hq = 0; hq < 2; ++hq) { const bf16* qr = Z + ((size_t)b * SEQ + 128 * n + r_) * NCOL + C_QB + (kvh * 4 + 2 * hp + hq) * 128 + 8 * g;
#pragma unroll
          for (int ks = 0; ks < 4; ++ks) qall[hq][ks] = *(const bf16x8*)(qr + 32 * ks); } }
    LDS_WAIT(); __syncthreads();
    const ImgAddr IA = make_img_addr(lane);
    const unsigned wo = 4096u * w;
    const unsigned bV = opaque(SW_V + wo + IA.TP);
    const int r = 16 * w + l15;
    for (int hh = 2 * hp; hh < 2 * hp + 2; ++hh) {
        const int h = kvh * 4 + hh;
        const float slope2 = exp2f(-(float)(h + 1)) * LOG2E, sink2 = F.sinks[layer * 8 + h] * LOG2E, c1 = 0.08838834764831845f * LOG2E;
        bf16x8 qf[4];
#pragma unroll
        for (int ks = 0; ks < 4; ++ks) qf[ks] = (hh & 1) ? qall[1][ks] : qall[0][ks];
        f32x4 st[10]; float m = -INFINITY;
#pragma unroll
        for (int i = 0; i < 9; ++i) { f32x4 a = (f32x4){0.f, 0.f, 0.f, 0.f};
#pragma unroll
            for (int ks = 0; ks < 4; ++ks) a = MFMA16(lds_frag(lds + SW_K + 4096 * i, wo + (IA.RB ^ (ks << 6))), qf[ks], a);
#pragma unroll
            for (int j = 0; j < 4; ++j) { const int key = 16 * (w + i) + 4 * g + j, dist = 128 + r - key; const bool ok = dist >= 0 && dist < 128 && (n > 0 || key >= 128);
                a[j] = ok ? a[j] * c1 - slope2 * (float)dist : -INFINITY; m = fmaxf(m, a[j]); }
            st[i] = a; }
        m = fmaxf(m, __shfl_xor(m, 16)); m = fmaxf(m, __shfl_xor(m, 32)); m = fmaxf(m, sink2);
        float sum = 0.f;
#pragma unroll
        for (int i = 0; i < 9; ++i)
#pragma unroll
            for (int j = 0; j < 4; ++j) { const float p = fexp2(fmaxf(st[i][j] - m, -125.0f)); st[i][j] = p; sum += p; }
        st[9] = (f32x4){0.f, 0.f, 0.f, 0.f};
        sum += __shfl_xor(sum, 16); sum += __shfl_xor(sum, 32);
        const float inv = frcp(sum + fexp2(fmaxf(sink2 - m, -125.0f)));
        f32x4 oc[8];
#pragma unroll
        for (int c = 0; c < 8; ++c) oc[c] = (f32x4){0.f, 0.f, 0.f, 0.f};
#pragma unroll
        for (int pp = 0; pp < 5; ++pp) { const bf16x8 pf = pack8(st[2 * pp], st[2 * pp + 1]);
#pragma unroll
            for (int c = 0; c < 8; ++c) oc[c] = MFMA16(pf, cat8(tr_read(lds + 4096 * (2 * pp), bV ^ (c << 5)), tr_read(lds + 4096 * (pp < 4 ? 2 * pp + 1 : 2 * pp), bV ^ (c << 5))), oc[c]); }
#pragma unroll
        for (int j = 0; j < 4; ++j) { const float iv = __shfl(inv, 4 * g + j); bf16* mr = MIX + ((size_t)b * SEQ + 128 * n + 16 * w + 4 * g + j) * DM + 512 + h * 128 + l15;
#pragma unroll
            for (int c = 0; c < 8; ++c) mr[16 * c] = (bf16)(pk2(oc[c][j] * iv, 0.f) & 0xffffu); }
    }
    LDS_WAIT(); __syncthreads();
}

__device__ __forceinline__ void sample_linrec_unit(Frame& F, int layer, int unit) {
    const int grp = unit >> 7, bh = unit & 127, b = bh >> 2, h = bh & 3, tid = F.tid;
    const float* zs = (const float*)(F.ws + WS_ZS) + (size_t)b * NCOL;
    const float* Sin = (grp ? F.state_ret : F.state_hgrn) + ((size_t)layer * DB * 4 + bh) * 16384;
    float* So = F.out + (grp ? O_SRET : O_SHGRN) + ((size_t)layer * DB * 4 + bh) * 16384;
    LAS float* red = (LAS float*)F.lds;
    LAS float* ov = (LAS float*)(F.lds + 8192);
    const int dvq = tid & 31, r0 = tid >> 5;
    const int cq = (grp ? C_QC : C_QA) + h * 128, cv = (grp ? C_VC : C_IA) + h * 128, cg = (grp ? C_GC : C_GA) + h * 128;
    const f32x4 v4 = *(const f32x4*)(zs + cv + 4 * dvq);
    const float gamma = 1.0f - exp2f(-5.0f - (float)h);
    f32x4 po = (f32x4){0.f, 0.f, 0.f, 0.f};
    f32x4 s4[8]; float qv[8], xv[8], la[8], lb2[8];
#pragma unroll
    for (int i = 0; i < 8; ++i) { const int dk = r0 + 16 * i; qv[i] = zs[cq + dk]; xv[i] = zs[(grp ? C_KC : C_FA) + h * 128 + dk]; la[i] = 0.f; lb2[i] = 0.f;
        if (grp == 0 && layer == 1) { la[i] = F.lbraw[h * 128 + dk]; lb2[i] = F.lbraw[512 + h * 128 + dk]; }
        s4[i] = *(const f32x4*)(Sin + (size_t)dk * 128 + 4 * dvq); }
#pragma unroll
    for (int i = 0; i < 8; ++i) { const int dk = r0 + 16 * i; const float q = qv[i]; float f, kk;
        if (grp == 0) { const float fa = xv[i]; float lb = 0.f; if (layer == 1) lb = 1.0f / (1.0f + __expf(la[i] - lb2[i]));
            const float e = __expf(-fabsf(fa)), inv = 1.0f / (1.0f + e), s = fa >= 0.f ? inv : e * inv, sm = fa >= 0.f ? e * inv : inv; f = lb + (1.0f - lb) * s; kk = (1.0f - lb) * sm; }
        else { f = gamma; kk = xv[i] * 0.08838834764831845f; }
        const f32x4 sn = s4[i] * f + v4 * kk;
        *(f32x4*)(So + (size_t)dk * 128 + 4 * dvq) = sn; po += sn * q; }
    *(LAS f32x4*)(red + r0 * 128 + 4 * dvq) = po;
    LDS_WAIT(); __syncthreads();
    if (tid < 128) { float s = 0.f;
#pragma unroll
        for (int i = 0; i < 16; ++i) s += red[i * 128 + tid];
        ov[tid] = s; }
    LDS_WAIT(); __syncthreads();
    if (F.wave == 0) { const int lane = F.lane; const float a0 = ov[lane], a1 = ov[64 + lane];
        const float mean = grp ? wave_sum(a0 + a1) * (1.0f / 128.0f) : 0.f; const float c0 = a0 - mean, c1 = a1 - mean;
        const float rr = 1.0f / sqrtf(wave_sum(c0 * c0 + c1 * c1) * (1.0f / 128.0f) + EPS);
        const float* gn = (grp ? F.ret_g : F.hgrn_g) + layer * 512 + h * 128; bf16* mo = (bf16*)(F.ws + WS_MIXS) + (size_t)b * DM + (grp ? 1536 : 0) + h * 128;
        mo[lane] = (bf16)(pk2(c0 * rr * gn[lane] * silu(zs[cg + lane]), 0.f) & 0xffffu); mo[64 + lane] = (bf16)(pk2(c1 * rr * gn[64 + lane] * silu(zs[cg + 64 + lane]), 0.f) & 0xffffu); }
    LDS_WAIT(); __syncthreads();
}
constexpr int SS_K = 0, SS_V = 67584, SS_ROW = 132;
__device__ __forceinline__ void sample_swa_unit(Frame& F, int layer, int unit) {
    const int tid = F.tid, lane = F.lane, b = unit >> 1, kvh = unit & 1;
    LAS float* Ks = (LAS float*)(F.lds + SS_K); LAS float* Vs = (LAS float*)(F.lds + SS_V);
    const float* zs = (const float*)(F.ws + WS_ZS) + (size_t)b * NCOL;
    const float* ck = F.cache_k + ((size_t)layer * DB + b) * 128 * 256 + kvh * 128; const float* cvv = F.cache_v + ((size_t)layer * DB + b) * 128 * 256 + kvh * 128;
#pragma unroll
    for (int i = 0; i < 8; ++i) { const int idx = tid + i * NTHR, j = idx >> 5, c4 = (idx & 31) * 4;
        const float* kr = j < 127 ? ck + (size_t)(j + 1) * 256 + c4 : zs + C_KB + kvh * 128 + c4; const float* vr = j < 127 ? cvv + (size_t)(j + 1) * 256 + c4 : zs + C_VB + kvh * 128 + c4;
        const f32x4 k4 = *(const f32x4*)kr, v4 = *(const f32x4*)vr;
        *(LAS f32x4*)(Ks + j * SS_ROW + c4) = k4; *(LAS f32x4*)(Vs + j * SS_ROW + c4) = v4; }
    LDS_WAIT(); __syncthreads();
    if (F.wave < 4) {
        const int h = kvh * 4 + F.wave; const float slope = exp2f(-(float)(h + 1)), sink = F.sinks[layer * 8 + h];
        float sc[2] = {0.f, 0.f};
#pragma unroll 8
        for (int d = 0; d < 128; d += 4) { const f32x4 q4 = *(const f32x4*)(zs + C_QB + h * 128 + d); const f32x4 ka = *(const LAS f32x4*)(Ks + lane * SS_ROW + d), kb = *(const LAS f32x4*)(Ks + (lane + 64) * SS_ROW + d);
            sc[0] += (ka[0] * q4[0] + ka[1] * q4[1]) + (ka[2] * q4[2] + ka[3] * q4[3]); sc[1] += (kb[0] * q4[0] + kb[1] * q4[1]) + (kb[2] * q4[2] + kb[3] * q4[3]); }
        sc[0] = sc[0] * 0.08838834764831845f - slope * (float)(127 - lane); sc[1] = sc[1] * 0.08838834764831845f - slope * (float)(63 - lane);
        const float m = fmaxf(wave_max(fmaxf(sc[0], sc[1])), sink);
        const float p0 = __expf(sc[0] - m), p1 = __expf(sc[1] - m);
        const float den = wave_sum(p0 + p1) + __expf(sink - m);
        float o0 = 0.f, o1 = 0.f;
#pragma unroll 16
        for (int j = 0; j < 128; ++j) { const float pj = __shfl(j < 64 ? p0 : p1, j & 63); const f32x2 v2 = *(const LAS f32x2*)(Vs + j * SS_ROW + 2 * lane); o0 += pj * v2.x; o1 += pj * v2.y; }
        *(unsigned*)((bf16*)(F.ws + WS_MIXS) + (size_t)b * DM + 512 + h * 128 + 2 * lane) = pk2(o0 / den, o1 / den);
    }
    LDS_WAIT(); __syncthreads();
}
__device__ __forceinline__ void kv_window_outputs(Frame& F, int layer, int rank, int count) {
    const bf16* Z = (const bf16*)(F.ws + WS_Z); const float* ZS = (const float*)(F.ws + WS_ZS);
    const size_t nthr = (size_t)count * NTHR, t0 = (size_t)rank * NTHR + F.tid;
    for (size_t q = t0; q < (size_t)BATCH * 128 * 64; q += nthr) { const size_t i = q * 4; const int c = (int)(i & 255), j = (int)((i >> 8) & 127), b = (int)(i >> 15); const size_t row = (size_t)b * SEQ + SEQ - 128 + j;
        const u32x2 kk = *(const u32x2*)(Z + row * NCOL + C_KB + c), vv = *(const u32x2*)(Z + row * NCOL + C_VB + c);
        *(f32x4*)(F.out + O_PK + (size_t)layer * BATCH * 32768 + i) = (f32x4){bflo(kk.x), bfhi(kk.x), bflo(kk.y), bfhi(kk.y)}; *(f32x4*)(F.out + O_PV + (size_t)layer * BATCH * 32768 + i) = (f32x4){bflo(vv.x), bfhi(vv.x), bflo(vv.y), bfhi(vv.y)}; }
    const float* ck = F.cache_k + (size_t)layer * DB * 32768; const float* cvv = F.cache_v + (size_t)layer * DB * 32768;
    for (size_t q = t0; q < (size_t)DB * 128 * 64; q += 2 * nthr) { f32x4 kk[2], vv[2];
#pragma unroll
        for (int e = 0; e < 2; ++e) { const size_t qq = q + e * nthr; if (qq < (size_t)DB * 128 * 64) { const size_t i = qq * 4; const int c = (int)(i & 255), j = (int)((i >> 8) & 127), b = (int)(i >> 15);
            kk[e] = j < 127 ? *(const f32x4*)(ck + i + 256) : *(const f32x4*)(ZS + (size_t)b * NCOL + C_KB + c); vv[e] = j < 127 ? *(const f32x4*)(cvv + i + 256) : *(const f32x4*)(ZS + (size_t)b * NCOL + C_VB + c); } }
#pragma unroll
        for (int e = 0; e < 2; ++e) { const size_t qq = q + e * nthr; if (qq < (size_t)DB * 128 * 64) { const size_t i = qq * 4;
            *(f32x4*)(F.out + O_SK + (size_t)layer * DB * 32768 + i) = kk[e]; *(f32x4*)(F.out + O_SV + (size_t)layer * DB * 32768 + i) = vv[e]; } } }
}
__device__ __forceinline__ void sample_mixers(Frame& F, int layer, int rank, int count) {
    for (int u = rank; u < 256; u += count) { F.tid = (int)opq_u32(threadIdx.x); F.lane = F.tid & 63; sample_linrec_unit(F, layer, u); }
    for (int u = rank - 64; u >= 0 && u < 64; u += count) { F.tid = (int)opq_u32(threadIdx.x); F.lane = F.tid & 63; sample_swa_unit(F, layer, u); }
}
__device__ __forceinline__ void p2a_mixers(Frame& F, int layer) {
    const int wg = F.bid, cnt = F.G;
#ifdef REP_CA2
    for (int rep_ = 0; rep_ < 2; ++rep_)
#endif
    for (int u0 = 4 * wg; u0 < 1024; u0 += 4 * cnt) { F.tid = (int)opq_u32(threadIdx.x); F.lane = F.tid & 63; chainA_units(F, u0, 4); }
    sample_mixers(F, layer, wg, cnt);
    F.tid = (int)opq_u32(threadIdx.x); F.lane = F.tid & 63;
    kv_window_outputs(F, layer, wg, cnt);
}
__device__ __forceinline__ void p2b_mixers(Frame& F, int layer) {
    chain_scan(F, layer);
    __syncthreads();
    for (int u = F.bid; u < 256; u += F.G) { F.tid = (int)opq_u32(threadIdx.x); F.lane = F.tid & 63; swa_prompt_unit(F, layer, u); }
}
__device__ __forceinline__ void p2c_mixers(Frame& F, int layer) {
#ifdef REP_CC2
    for (int rep_ = 0; rep_ < 2; ++rep_)
#endif
    for (int u0 = 4 * F.bid; u0 < 1024; u0 += 4 * F.G) { F.tid = (int)opq_u32(threadIdx.x); F.lane = F.tid & 63; chainC_units(F, layer, u0, 4); }
}
constexpr size_t WS_UH = WS_U + 100 * MiB;
__device__ __forceinline__ void p5_conv(Frame& F, int layer) {
    const float* UH = (const float*)(F.ws + WS_UH); bf16* HF = (bf16*)(F.ws + WS_HF);
    const float* cw = F.conv_w + (size_t)layer * 3 * NUP; const float* cb = F.conv_b + (size_t)layer * NUP;
    const size_t nthr = (size_t)F.G * NTHR, t0 = (size_t)F.vcu * NTHR + F.tid;
    constexpr size_t N_FIX = (size_t)32 * 44 * 2 * 128;
    for (size_t base = t0; base < N_FIX; base += 3 * nthr) { float u0[3][2], u1[3][2], u2[3][2], w0[3][2], w1[3][2], w2[3][2], bb[3][2]; bool on[3];
#pragma unroll
        for (int e = 0; e < 3; ++e) { const size_t it = base + e * nthr; on[e] = false; if (it < N_FIX) {
            const int i = (int)(it & 127), t = (int)((it >> 7) & 1), pn = (int)((it >> 8) % 44), pm = (int)((it >> 8) / 44);
            if ((pm & 7) != 0) { on[e] = true; const float* cur = UH + (size_t)(pm * 44 + pn) * 1024; const float* prv = UH + (size_t)((pm - 1) * 44 + pn) * 1024;
#pragma unroll
                for (int hf = 0; hf < 2; ++hf) { const int ct = hf * 128 + i, col = hf * DFF + 128 * pn + i;
                    u0[e][hf] = cur[t * 256 + ct]; u1[e][hf] = t == 0 ? prv[3 * 256 + ct] : cur[ct]; u2[e][hf] = t == 0 ? prv[2 * 256 + ct] : prv[3 * 256 + ct];
                    bb[e][hf] = cb[col]; w0[e][hf] = cw[col]; w1[e][hf] = cw[NUP + col]; w2[e][hf] = cw[2 * NUP + col]; } } } }
#pragma unroll
        for (int e = 0; e < 3; ++e) if (on[e]) { const size_t it = base + e * nthr; const int i = (int)(it & 127), t = (int)((it >> 7) & 1), pn = (int)((it >> 8) % 44), pm = (int)((it >> 8) / 44);
            const float c0 = bb[e][0] + w0[e][0] * u2[e][0] + w1[e][0] * u1[e][0] + w2[e][0] * u0[e][0], c1 = bb[e][1] + w0[e][1] * u2[e][1] + w1[e][1] * u1[e][1] + w2[e][1] * u0[e][1];
            HF[(size_t)(256 * pm + t) * DFF + 128 * pn + i] = (bf16)(pk2(gelu_tanh(c0) * c1, 0.f) & 0xffffu); }
    }
    for (size_t it = t0; it < (size_t)BATCH * 2 * NUP; it += nthr) {
        const int col = (int)(it % NUP), r = (int)((it / NUP) & 1), b = (int)(it / (2 * NUP)); const int hf = col >= DFF ? 1 : 0, cg = col - hf * DFF, pn = cg >> 7, i = cg & 127;
        F.out[O_PCONV + (((size_t)layer * BATCH + b) * 2 + r) * NUP + col] = UH[(size_t)((8 * b + 7) * 44 + pn) * 1024 + (2 + r) * 256 + hf * 128 + i];
    }
    const float* US = (const float*)(F.ws + WS_US); const float* pre = F.state_conv + (size_t)layer * DB * 2 * NUP; bf16* HFS = (bf16*)(F.ws + WS_HFS);
    for (size_t base = t0; base < (size_t)DB * DFF; base += 2 * nthr) { float u0[2][2], q0[2][2], q1[2][2], w0[2][2], w1[2][2], w2[2][2], bb[2][2];
#pragma unroll
        for (int e = 0; e < 2; ++e) { const size_t i = base + e * nthr; if (i < (size_t)DB * DFF) { const int j = (int)(i % DFF), b = (int)(i / DFF);
#pragma unroll
            for (int hf = 0; hf < 2; ++hf) { const int col = hf * DFF + j, ucol = 256 * (j >> 7) + 128 * hf + (j & 127); u0[e][hf] = US[(size_t)b * NUP + ucol];
                q0[e][hf] = pre[((size_t)b * 2 + 0) * NUP + col]; q1[e][hf] = pre[((size_t)b * 2 + 1) * NUP + col];
                bb[e][hf] = cb[col]; w0[e][hf] = cw[col]; w1[e][hf] = cw[NUP + col]; w2[e][hf] = cw[2 * NUP + col]; } } }
#pragma unroll
        for (int e = 0; e < 2; ++e) { const size_t i = base + e * nthr; if (i < (size_t)DB * DFF) { const int j = (int)(i % DFF), b = (int)(i / DFF); float c[2];
#pragma unroll
            for (int hf = 0; hf < 2; ++hf) { const int col = hf * DFF + j; c[hf] = bb[e][hf] + w0[e][hf] * q0[e][hf] + w1[e][hf] * q1[e][hf] + w2[e][hf] * u0[e][hf];
                float* so = F.out + O_SCONV + ((size_t)layer * DB + b) * 2 * NUP; so[col] = q1[e][hf]; so[NUP + col] = u0[e][hf]; }
            HFS[i] = (bf16)(pk2(gelu_tanh(c[0]) * c[1], 0.f) & 0xffffu); } }
    }
}
__device__ __forceinline__ void p_final(Frame& F) {
    const int gw = F.vcu * NWAVES + F.wave, NGW = F.G * NWAVES, lane = F.lane; const float* SS = (const float*)(F.ws + WS_SS); const bf16* XBp = (const bf16*)(F.ws + WS_XB);
    { f32x4 g0[4], g1[4];
#pragma unroll
      for (int j = 0; j < 4; ++j) { g0[j] = ((const f32x4*)F.fin_g)[(lane + 64 * j) * 2]; g1[j] = ((const f32x4*)F.fin_g)[(lane + 64 * j) * 2 + 1]; }
      u32x4 h[4], hn[4]; f32x4 sa, sb, san, sbn; int m = gw;
      if (m < MP) { const u32x4* hb = (const u32x4*)(XBp + (size_t)m * DM) + lane;
#pragma unroll
          for (int j = 0; j < 4; ++j) h[j] = hb[64 * j];
          sa = *(const f32x4*)(SS + (size_t)m * 8); sb = *(const f32x4*)(SS + (size_t)m * 8 + 4); }
      while (m < MP) { const int mn = m + NGW; const bool more = mn < MP;
          if (more) { const u32x4* hb = (const u32x4*)(XBp + (size_t)mn * DM) + lane;
#pragma unroll
              for (int j = 0; j < 4; ++j) hn[j] = hb[64 * j];
              san = *(const f32x4*)(SS + (size_t)mn * 8); sbn = *(const f32x4*)(SS + (size_t)mn * 8 + 4); }
          const float ssum = ((sa[0] + sa[1]) + (sa[2] + sa[3])) + ((sb[0] + sb[1]) + (sb[2] + sb[3])); const float r = 1.0f / sqrtf(ssum * (1.0f / 2048.0f) + 1e-6f);
          float* orow = F.out + O_YP + (size_t)m * DM;
#pragma unroll
          for (int j = 0; j < 4; ++j) { f32x4 v0, v1; v0[0] = bflo(h[j].x); v0[1] = bfhi(h[j].x); v0[2] = bflo(h[j].y); v0[3] = bfhi(h[j].y); v1[0] = bflo(h[j].z); v1[1] = bfhi(h[j].z); v1[2] = bflo(h[j].w); v1[3] = bfhi(h[j].w);
              ((f32x4*)orow)[(lane + 64 * j) * 2] = v0 * r * g0[j]; ((f32x4*)orow)[(lane + 64 * j) * 2 + 1] = v1 * r * g1[j]; }
          if (more) {
#pragma unroll
              for (int j = 0; j < 4; ++j) h[j] = hn[j];
              sa = san; sb = sbn; }
          m = mn; } }
    if (gw < DB) { const int q = gw; const f32x4* x4 = (const f32x4*)((const float*)(F.ws + WS_XS) + (size_t)q * DM) + lane; float* orow = F.out + O_YS + (size_t)q * DM; f32x4 v[8], gg[8]; float s = 0.f;
#pragma unroll
        for (int j = 0; j < 8; ++j) { v[j] = x4[64 * j]; gg[j] = ((const f32x4*)F.fin_g + lane)[64 * j]; }
#pragma unroll
        for (int j = 0; j < 8; ++j) s += (v[j][0] * v[j][0] + v[j][1] * v[j][1]) + (v[j][2] * v[j][2] + v[j][3] * v[j][3]);
        const float r = 1.0f / sqrtf(wave_sum(s) * (1.0f / DM) + EPS);
#pragma unroll
        for (int j = 0; j < 8; ++j) ((f32x4*)orow + lane)[64 * j] = v[j] * r * gg[j]; }
}
}
constexpr int N_PHASES = 18;
__global__ void __launch_bounds__(mk::NTHR, 2) mk_fwd(mk::Args args) {
    using namespace mk;
    extern __shared__ __attribute__((aligned(16))) unsigned char lds_raw[];
    Frame F;
    F.lds = (LAS unsigned char*)lds_raw;
    F.tid = threadIdx.x; F.lane = F.tid & 63; F.wave = __builtin_amdgcn_readfirstlane(F.tid >> 6);
    F.G = gridDim.x; F.bid = blockIdx.x; F.vcu = F.bid;
    F.ws = args.ws; F.out = args.out;
    F.x_prompt = args.in[0]; F.x_sample = args.in[1]; F.state_hgrn = args.in[2]; F.cache_k = args.in[3]; F.cache_v = args.in[4]; F.state_ret = args.in[5]; F.state_conv = args.in[6];
    F.norm1 = args.in[7]; F.w_in = args.in[8]; F.lbraw = args.in[9]; F.hgrn_g = args.in[10]; F.sinks = args.in[11]; F.ret_g = args.in[12]; F.w_out = args.in[13]; F.norm2 = args.in[14];
    F.w_up = args.in[15]; F.conv_w = args.in[16]; F.conv_b = args.in[17]; F.w_down = args.in[18]; F.fin_g = args.in[19];
    volatile LAS unsigned* MISC = (volatile LAS unsigned*)(F.lds + MISC_OFF);
    for (int u = F.tid; u < 256; u += NTHR) MISC[u] = 0u;
    __syncthreads();
    const int lo = args.ph_lo, hi = args.ph_hi;
    XcdBarrier bar; bar.bar = (unsigned*)(F.ws + WS_CTL) + CW_BAR; bar.x = 0; bar.st = nullptr;
    if (hi - lo > 1) bar = xcd_barrier_post((unsigned*)(F.ws + WS_CTL) + CW_BAR, MISC + 8);
#define REFRESH() do { F.tid = (int)opq_u32(threadIdx.x); F.lane = F.tid & 63; F.wave = __builtin_amdgcn_readfirstlane(F.tid >> 6); F.bid = __builtin_amdgcn_readfirstlane((int)opq_u32(blockIdx.x)); F.vcu = (F.G % 8 == 0) ? (F.bid % 8) * (F.G / 8) + F.bid / 8 : F.bid; } while (0)
#define IN(k) (lo <= (k) && (k) < hi)
#define NREP(k) (((args.rep_mask >> (k)) & 1u) ? 2 : 1)
#define REPSYNC() do { if (rep) xcd_barrier(bar); } while (0)
#define SEAM(k) do { if (IN(k) && IN((k) + 1)) xcd_barrier(bar); } while (0)
    bf16* XB = (bf16*)(F.ws + WS_XB); float* SS = (float*)(F.ws + WS_SS);
    if (IN(0)) for (int rep = 0; rep < NREP(0); ++rep) { REPSYNC(); REFRESH();
#ifndef SKIP_P0
 p0_prologue(F);
#endif
 } SEAM(0);
#pragma unroll 1
    for (int l = 0; l < DEPTH; ++l) {
        const int base = 1 + 8 * l;
        if (IN(base)) for (int rep = 0; rep < NREP(base); ++rep) { REPSYNC(); REFRESH();
            pg8::Gemm g{XB, (const bf16*)(F.ws + WS_WIN + l * SZ_WIN), MP, NCOL, DM}; pg8::InProjOrder S; S.init(MP, NCOL, F.G, F.bid);
            pg8::EpiZ E{(bf16*)(F.ws + WS_Z), (float*)(F.ws + WS_LOGF), SS, F.lbraw, l, NCOL, (LAS float*)(F.lds + 131072 + 16384)};

#ifndef SKIP_G1
 pg8::gemm_phase<pg8::EpiZ, pg8::InProjOrder, true, true>(F.lds, g, S, E);
#endif


#ifndef SKIP_SG
 REFRESH(); sample_gemm_phase(F, 1, l, F.bid - 192, 64);
#endif

        } SEAM(base);
        if (IN(base + 1)) for (int rep = 0; rep < NREP(base + 1); ++rep) { REPSYNC(); REFRESH();
 p2a_mixers(F, l);
 } SEAM(base + 1);
        if (IN(base + 2)) for (int rep = 0; rep < NREP(base + 2); ++rep) { REPSYNC(); REFRESH();
 p2b_mixers(F, l);
 } SEAM(base + 2);
        if (IN(base + 3)) for (int rep = 0; rep < NREP(base + 3); ++rep) { REPSYNC(); REFRESH();
 p2c_mixers(F, l);
 } SEAM(base + 3);
        if (IN(base + 4)) for (int rep = 0; rep < NREP(base + 4); ++rep) { REPSYNC(); REFRESH();
            if (!rep) { sample_kpart(F, 2, l, (unsigned*)(F.ws + WS_CTL) + CW_SUB + 64 * (2 * l)); REFRESH(); }
            pg8::Gemm g{(const bf16*)(F.ws + WS_MIX), (const bf16*)(F.ws + WS_WOUT + l * SZ_WOUT), MP, DM, DM}; pg8::StaticOrder S; S.init(MP, DM, F.G, F.bid);
            pg8::EpiRes E{l == 0 ? F.x_prompt : nullptr, XB, rep ? (bf16*)(F.ws + WS_U + 128 * MiB) : XB, rep ? (float*)(F.ws + WS_U + 128 * MiB + (size_t)MP * DM * 4) : SS};

#ifndef SKIP_GR
 pg8::gemm_phase<pg8::EpiRes, pg8::StaticOrder, false, true>(F.lds, g, S, E);
#endif


#ifndef SKIP_SG
 REFRESH(); if (!rep) { if (F.G == 256) sample_kreduce(F, (unsigned*)(F.ws + WS_CTL) + CW_SUB + 64 * (2 * l), bar.bar); else sample_gemm_phase(F, 2, l, F.bid, 64); }
#endif

        } SEAM(base + 4);
        if (IN(base + 5)) for (int rep = 0; rep < NREP(base + 5); ++rep) { REPSYNC(); REFRESH();
            pg8::Gemm g{XB, (const bf16*)(F.ws + WS_WUP + l * SZ_WUP), MP, NUP, DM}; pg8::StaticOrder S; S.init(MP, NUP, F.G, F.bid);
            pg8::EpiUF E{(bf16*)(F.ws + WS_HF), (float*)(F.ws + WS_UH), SS, F.conv_w + (size_t)l * 3 * NUP, F.conv_b + (size_t)l * NUP, (LAS float*)(F.lds + 131072)};

#ifndef SKIP_G3
 pg8::gemm_phase<pg8::EpiUF, pg8::StaticOrder, true, true>(F.lds, g, S, E);
#endif


#ifndef SKIP_SG
 REFRESH(); sample_gemm_phase(F, 3, l, F.bid - 128, 128);
#endif

        } SEAM(base + 5);
        if (IN(base + 6)) for (int rep = 0; rep < NREP(base + 6); ++rep) { REPSYNC(); REFRESH();
#ifndef SKIP_P5
 p5_conv(F, l);
#endif
 } SEAM(base + 6);
        if (IN(base + 7)) for (int rep = 0; rep < NREP(base + 7); ++rep) { REPSYNC(); REFRESH();
            if (!rep) { sample_kpart(F, 4, l, (unsigned*)(F.ws + WS_CTL) + CW_SUB + 64 * (2 * l + 1)); REFRESH(); }
            pg8::Gemm g{(const bf16*)(F.ws + WS_HF), (const bf16*)(F.ws + WS_WDN + l * SZ_WDN), MP, DM, DFF}; pg8::StaticOrder S; S.init(MP, DM, F.G, F.bid);
            pg8::EpiRes E{nullptr, XB, rep ? (bf16*)(F.ws + WS_U + 128 * MiB) : XB, rep ? (float*)(F.ws + WS_U + 128 * MiB + (size_t)MP * DM * 4) : SS};

#ifndef SKIP_GR
 pg8::gemm_phase<pg8::EpiRes, pg8::StaticOrder, false, true>(F.lds, g, S, E);
#endif


#ifndef SKIP_SG
 REFRESH(); if (!rep) { if (F.G == 256) sample_kreduce(F, (unsigned*)(F.ws + WS_CTL) + CW_SUB + 64 * (2 * l + 1), bar.bar); else sample_gemm_phase(F, 4, l, F.bid, 64); }
#endif

        } SEAM(base + 7);
    }

#ifndef SKIP_PF
 if (IN(17)) { REFRESH(); p_final(F); }
#endif

#undef IN
#undef SEAM
}

static void mk_forward(void* const* d_in, float* out, void* d_ws, hipStream_t stream, int per_phase) {
    static int ready = 0;
    if (!ready) { hipFuncSetAttribute((const void*)mk_fwd, hipFuncAttributeMaxDynamicSharedMemorySize, mk::LDS_BYTES); ready = 1; }
    hipMemsetAsync((char*)d_ws + mk::WS_CTL, 0, mk::CTL_ZERO_BYTES, stream);
    mk::Args a{};
    for (int i = 0; i < 20; ++i) a.in[i] = (const float*)d_in[i];
    a.out = out; a.ws = (unsigned char*)d_ws;
#ifdef REP_MASK
    a.rep_mask = REP_MASK;
#endif
    if (per_phase) { for (int p = 0; p < N_PHASES; ++p) { a.ph_lo = p; a.ph_hi = p + 1; hipLaunchKernelGGL(mk_fwd, dim3(256), dim3(mk::NTHR), mk::LDS_BYTES, stream, a); } }
    else { a.ph_lo = 0; a.ph_hi = N_PHASES; hipLaunchKernelGGL(mk_fwd, dim3(256), dim3(mk::NTHR), mk::LDS_BYTES, stream, a); }
}
#ifndef MK_PER_PHASE
#define MK_PER_PHASE 0
#endif
extern "C" void kernel_launch(void* const* d_in, const int* in_sizes, int n_in, void* d_out, int out_size, void* d_ws, size_t ws_size, hipStream_t stream) {
    if (n_in != 20 || out_size != (int)cfg::O_END || ws_size < mk::WS_END + (2u << 20)) { fprintf(stderr, "kernel_launch: unexpected shapes n_in %d out %d ws %zu\n", n_in, out_size, ws_size); return; }
    mk_forward(d_in, (float*)d_out, d_ws, stream, MK_PER_PHASE);
}
```
